# Optimizing an MI355X kernel written in HIP

```python
import jax, jax.numpy as jnp
from jax import lax
import numpy as np

D_MODEL = 1024
BATCH = 1
SEQ = 16384
DEPTH = 1

HEAD_DIM = 64
N_FOX_HEADS = 8
N_DIL_HEADS = 8
FOX_WIDTH = N_FOX_HEADS * HEAD_DIM
DIL_WIDTH = N_DIL_HEADS * HEAD_DIM
MIX_WIDTH = FOX_WIDTH + DIL_WIDTH
DILATED_PATTERNS = ((128, 1), (512, 4), (2048, 16))
Q_BLOCK = 128
N_MEM = 256
N_MEM_HEADS = 4
MEM_WIDTH = N_MEM_HEADS * HEAD_DIM
N_BUCKETS = 32
MAX_DISTANCE = 2048
D_FF = -(-8 * D_MODEL // (3 * 256)) * 256
RMS_EPS = 1e-6
IN_SIZES = (FOX_WIDTH, FOX_WIDTH, FOX_WIDTH, N_FOX_HEADS, DIL_WIDTH, DIL_WIDTH, DIL_WIDTH)
IN_COLS = sum(IN_SIZES)

kernel_name = "hybrid_fox_dilated_memxattn_swiglu"


def rmsnorm(x, g):
    xf = x.astype(jnp.float32)
    y = xf * lax.rsqrt(jnp.mean(xf * xf, axis=-1, keepdims=True) + RMS_EPS)
    return (y * g.astype(jnp.float32)).astype(x.dtype)


def split_heads(t, n):
    B, S, _ = t.shape
    return t.reshape(B, S, n, HEAD_DIM).transpose(0, 2, 1, 3)


def merge_heads(t):
    B, H, S, Dh = t.shape
    return t.transpose(0, 2, 1, 3).reshape(B, S, H * Dh)


def t5_causal_bucket(dist):
    max_exact = N_BUCKETS // 2
    d = np.maximum(dist, 1).astype(np.float32)
    large = max_exact + (np.log(d / max_exact) / np.log(MAX_DISTANCE / max_exact)
                         * (N_BUCKETS - max_exact)).astype(np.int32)
    large = np.minimum(large, N_BUCKETS - 1)
    return np.where(dist < max_exact, dist, large).astype(np.int32)


def forgetting_attention(q, k, v, log_f):
    B, H, S, Dh = q.shape
    nb = S // Q_BLOCK
    c = jnp.cumsum(log_f, axis=-1)
    qb = q.reshape(B, H, nb, Q_BLOCK, Dh).transpose(2, 0, 1, 3, 4)
    cb = c.reshape(B, H, nb, Q_BLOCK).transpose(2, 0, 1, 3)
    key_pos = jnp.arange(S)
    scale = Dh ** -0.5

    def block(args):
        qi, ci, i = args
        s = jnp.einsum('bhqd,bhkd->bhqk', qi, k).astype(jnp.float32) * scale
        s = s + ci[..., :, None] - c[..., None, :]
        q_pos = i * Q_BLOCK + jnp.arange(Q_BLOCK)
        s = jnp.where(key_pos[None, :] <= q_pos[:, None], s, -jnp.inf)
        p = jax.nn.softmax(s, axis=-1)
        return jnp.einsum('bhqk,bhkd->bhqd', p.astype(v.dtype), v)

    o = lax.map(block, (qb, cb, jnp.arange(nb)))
    return o.transpose(1, 2, 0, 3, 4).reshape(B, H, S, Dh)


def dilated_branch(q, k, v, rel_bias, window, dilation):
    B, H, S, Dh = q.shape
    w = window // dilation
    span = w * dilation
    S_pad = -(-S // span) * span
    L = S_pad // dilation
    nb = L // w

    def split(t):
        t = jnp.pad(t, ((0, 0), (0, 0), (0, S_pad - S), (0, 0)))
        t = t.reshape(B, H, L, dilation, Dh).transpose(0, 1, 3, 2, 4)
        return t.reshape(B, H, dilation, nb, w, Dh)

    def with_prev(t):
        prev = jnp.pad(t[:, :, :, :-1], ((0, 0), (0, 0), (0, 0), (1, 0), (0, 0), (0, 0)))
        return jnp.concatenate([prev, t], axis=4)

    qs = split(q)
    kk = with_prev(split(k))
    vv = with_prev(split(v))
    s = jnp.einsum('bhrnqd,bhrnkd->bhrnqk', qs, kk).astype(jnp.float32) * (Dh ** -0.5)

    qi = np.arange(w)[:, None]
    kj = np.arange(2 * w)[None, :]
    sub_dist = qi + w - kj
    band = (sub_dist >= 0) & (sub_dist <= w)
    bucket = t5_causal_bucket(np.clip(sub_dist, 0, w) * dilation)
    bias = rel_bias.astype(jnp.float32)[bucket]
    s = s + jnp.transpose(bias, (2, 0, 1))[None, :, None, None]
    not_first = (np.arange(nb)[:, None, None] > 0) | (kj[None] >= w)
    mask = jnp.asarray(band[None] & not_first)
    s = jnp.where(mask, s, -jnp.inf)

    m = jnp.max(s, axis=-1, keepdims=True)
    e = jnp.exp(s - m)
    l = jnp.sum(e, axis=-1, keepdims=True)
    o = jnp.einsum('bhrnqk,bhrnkd->bhrnqd', (e / l).astype(v.dtype), vv)
    lse = (m + jnp.log(l))[..., 0]

    def merge(t):
        t = t.reshape(B, H, dilation, L, *t.shape[5:])
        t = jnp.moveaxis(t, 2, 3)
        t = t.reshape(B, H, S_pad, *t.shape[4:])
        return t[:, :, :S]

    return merge(o), merge(lse)


def dilated_attention(q, k, v, rel_bias):
    outs, lses = [], []
    for window, dilation in DILATED_PATTERNS:
        o, lse = dilated_branch(q, k, v, rel_bias, window, dilation)
        outs.append(o)
        lses.append(lse)
    alpha = jax.nn.softmax(jnp.stack(lses, axis=0), axis=0)
    return jnp.einsum('pbhs,pbhsd->bhsd', alpha.astype(v.dtype), jnp.stack(outs, axis=0))


def memory_cross_attention(h, hm, w_xq, w_xk, w_xv, w_xo):
    q = split_heads(h @ w_xq, N_MEM_HEADS)
    k = split_heads(hm @ w_xk, N_MEM_HEADS)
    v = split_heads(hm @ w_xv, N_MEM_HEADS)
    s = jnp.einsum('bhqd,bhkd->bhqk', q, k).astype(jnp.float32) * (HEAD_DIM ** -0.5)
    p = jax.nn.softmax(s, axis=-1)
    o = jnp.einsum('bhqk,bhkd->bhqd', p.astype(v.dtype), v)
    return merge_heads(o) @ w_xo


def setup_inputs(seed: int = 0) -> dict:
    key = jax.random.key(seed)
    ks = jax.random.split(key, 24)
    nrm = jax.random.normal

    def w(k, shape, fan_in):
        return nrm(k, shape, jnp.float32) * fan_in ** -0.5

    def gain(k):
        return 1.0 + 0.1 * nrm(k, (DEPTH, D_MODEL), jnp.float32)

    return {
        "x": nrm(ks[0], (BATCH, SEQ, D_MODEL), jnp.float32),
        "mem": nrm(ks[1], (BATCH, N_MEM, D_MODEL), jnp.float32),
        "g_mix_pre": gain(ks[2]),
        "w_in": w(ks[3], (DEPTH, D_MODEL, IN_COLS), D_MODEL),
        "b_f": 2.0 + 0.5 * nrm(ks[4], (DEPTH, N_FOX_HEADS), jnp.float32),
        "rel_bias": 0.5 * nrm(ks[5], (N_BUCKETS, N_DIL_HEADS), jnp.float32),
        "w_out": w(ks[6], (DEPTH, MIX_WIDTH, D_MODEL), MIX_WIDTH),
        "g_mix_post": gain(ks[7]),
        "g_xattn_pre": gain(ks[8]),
        "g_mem": gain(ks[9]),
        "w_xq": w(ks[10], (DEPTH, D_MODEL, MEM_WIDTH), D_MODEL),
        "w_xk": w(ks[11], (DEPTH, D_MODEL, MEM_WIDTH), D_MODEL),
        "w_xv": w(ks[12], (DEPTH, D_MODEL, MEM_WIDTH), D_MODEL),
        "w_xo": w(ks[13], (DEPTH, MEM_WIDTH, D_MODEL), MEM_WIDTH),
        "g_xattn_post": gain(ks[14]),
        "g_ffn_pre": gain(ks[15]),
        "w_gate": w(ks[16], (DEPTH, D_MODEL, D_FF), D_MODEL),
        "w_up": w(ks[17], (DEPTH, D_MODEL, D_FF), D_MODEL),
        "w_down": w(ks[18], (DEPTH, D_FF, D_MODEL), D_FF),
        "g_ffn_post": gain(ks[19]),
    }


def reference(x, mem, g_mix_pre, w_in, b_f, rel_bias, w_out, g_mix_post,
              g_xattn_pre, g_mem, w_xq, w_xk, w_xv, w_xo, g_xattn_post,
              g_ffn_pre, w_gate, w_up, w_down, g_ffn_post):
    split_points = [int(p) for p in np.cumsum(IN_SIZES)[:-1]]
    for layer in range(DEPTH):
        h = rmsnorm(x, g_mix_pre[layer])
        proj = h @ w_in[layer]
        fq, fk, fv, fgate, dq, dk, dv = jnp.split(proj, split_points, axis=-1)
        log_f = jax.nn.log_sigmoid((fgate + b_f[layer]).astype(jnp.float32))
        log_f = log_f.transpose(0, 2, 1)
        o_fox = forgetting_attention(split_heads(fq, N_FOX_HEADS), split_heads(fk, N_FOX_HEADS),
                                     split_heads(fv, N_FOX_HEADS), log_f)
        o_dil = dilated_attention(split_heads(dq, N_DIL_HEADS), split_heads(dk, N_DIL_HEADS),
                                  split_heads(dv, N_DIL_HEADS), rel_bias)
        o = merge_heads(jnp.concatenate([o_fox, o_dil], axis=1))
        x = x + rmsnorm(o @ w_out[layer], g_mix_post[layer])

        h = rmsnorm(x, g_xattn_pre[layer])
        hm = rmsnorm(mem, g_mem[layer])
        y = memory_cross_attention(h, hm, w_xq[layer], w_xk[layer], w_xv[layer], w_xo[layer])
        x = x + rmsnorm(y, g_xattn_post[layer])

        h = rmsnorm(x, g_ffn_pre[layer])
        y = (jax.nn.silu(h @ w_gate[layer]) * (h @ w_up[layer])) @ w_down[layer]
        x = x + rmsnorm(y, g_ffn_post[layer])
    return x
```

```cpp
#include <hip/hip_runtime.h>
#include <cstdint>
#include <cstdio>

#define LAS __attribute__((address_space(3)))
typedef unsigned short bf16_t;
typedef short bf16x8 __attribute__((ext_vector_type(8)));
typedef float f32x4 __attribute__((ext_vector_type(4)));
typedef float f32x16 __attribute__((ext_vector_type(16)));
typedef unsigned u32x4 __attribute__((ext_vector_type(4)));
typedef unsigned u32x2 __attribute__((ext_vector_type(2)));

constexpr int SEQ = 16384, DM = 1024, NMEM = 256, DFF = 2816;
constexpr int IN_COLS = 3080;
constexpr int NQKV = 3072;
constexpr int NGU = 2 * DFF;
constexpr float RMS_EPS = 1e-6f;
constexpr float LOG2E = 1.4426950408889634f;
constexpr float C2 = 0.125f * LOG2E;
constexpr int BT_STRIDE = 132;

constexpr size_t MiB = 1u << 20;
constexpr size_t WS_CTL = 0;
constexpr size_t WS_WIN = 1 * MiB;
constexpr size_t WS_WOUT = 7 * MiB;
constexpr size_t WS_WXQ = 9 * MiB;
constexpr size_t WS_WXO = 9 * MiB + 512 * 1024;
constexpr size_t WS_WGU = 10 * MiB;
constexpr size_t WS_WDN = 21 * MiB;
constexpr size_t WS_QKV = 28 * MiB;
constexpr size_t WS_QX = 28 * MiB;
constexpr size_t WS_OX = 36 * MiB;
constexpr size_t WS_HMID = 28 * MiB;
constexpr size_t WS_H1 = 124 * MiB;
constexpr size_t WS_H3 = 124 * MiB;
constexpr size_t WS_O = 156 * MiB;
constexpr size_t WS_H2 = 156 * MiB;
constexpr size_t WS_Y = 188 * MiB;
constexpr size_t WS_LOGF = 252 * MiB;
constexpr size_t WS_C = 252 * MiB + 512 * 1024;
constexpr size_t WS_KMEM = 253 * MiB;
constexpr size_t WS_VMEM = 253 * MiB + 128 * 1024;
constexpr size_t WS_BTAB = 253 * MiB + 256 * 1024;
constexpr size_t WS_END = 256 * MiB;

__device__ __forceinline__ unsigned f2bf(float f) { unsigned u = __float_as_uint(f); return (u + 0x7fffu + ((u >> 16) & 1u)) >> 16; }
__device__ __forceinline__ unsigned pk2(float lo, float hi) { return f2bf(lo) | (f2bf(hi) << 16); }
__device__ __forceinline__ float bf2f(bf16_t b) { return __uint_as_float(((unsigned)b) << 16); }
__device__ __forceinline__ float wave_sum(float v) {
#pragma unroll
    for (int o = 1; o < 64; o <<= 1) v += __shfl_xor(v, o);
    return v;
}
__device__ __forceinline__ int t5_bucket(int dist) {
    if (dist < 16) return dist;
    int b = 16;
    b += dist >= 22; b += dist >= 30; b += dist >= 40; b += dist >= 54; b += dist >= 73; b += dist >= 99; b += dist >= 134; b += dist >= 182;
    b += dist >= 246; b += dist >= 332; b += dist >= 450; b += dist >= 609; b += dist >= 825; b += dist >= 1117; b += dist >= 1513;
    return b;
}

struct Ptrs {
    const float* in[20];
    float* out;
    unsigned char* ws;
};

__device__ __forceinline__ void p0_transpose_item(const float* W, int ldw, int scol0, bf16_t* WT, int ldt, int drow0, int k0, LAS float* scr, int lane) {
#pragma unroll 8
    for (int i = 0; i < 32; ++i) { const int kk = 2 * i + (lane >> 5); scr[kk * 33 + (lane & 31)] = W[(size_t)(k0 + kk) * ldw + scol0 + (lane & 31)]; }
    asm volatile("s_waitcnt lgkmcnt(0)" ::: "memory");
    const int c = lane & 7;
#pragma unroll
    for (int j = 0; j < 4; ++j) { const int n = (lane >> 3) + 8 * j; const LAS float* s = scr + (8 * c) * 33 + n;
        u32x4 o; o.x = pk2(s[0 * 33], s[1 * 33]); o.y = pk2(s[2 * 33], s[3 * 33]); o.z = pk2(s[4 * 33], s[5 * 33]); o.w = pk2(s[6 * 33], s[7 * 33]);
        *(u32x4*)(WT + (size_t)(drow0 + n) * ldt + k0 + 8 * c) = o; }
    asm volatile("s_waitcnt lgkmcnt(0)" ::: "memory");
}

__device__ __forceinline__ void p0_weights(const Ptrs& P, LAS float* scr, int gw, int ngw, int lane) {
    unsigned char* ws = P.ws;
    bf16_t* Win = (bf16_t*)(ws + WS_WIN); bf16_t* Wout = (bf16_t*)(ws + WS_WOUT); bf16_t* Wxq = (bf16_t*)(ws + WS_WXQ); bf16_t* Wxo = (bf16_t*)(ws + WS_WXO);
    bf16_t* Wgu = (bf16_t*)(ws + WS_WGU); bf16_t* Wdn = (bf16_t*)(ws + WS_WDN);
    constexpr int I_IN = (DM / 64) * (1536 / 32);
    constexpr int I_OUT = (DM / 64) * (DM / 32);
    constexpr int I_XQ = (DM / 64) * (256 / 32);
    constexpr int I_XO = (256 / 64) * (DM / 32);
    constexpr int I_G = (DM / 64) * (DFF / 32);
    constexpr int I_DN = (DFF / 64) * (DM / 32);
    constexpr int NITEMS = 2 * I_IN + I_OUT + I_XQ + I_XO + 2 * I_G + I_DN;
    for (int it = gw; it < NITEMS; it += ngw) {
        int r = it;
        if (r < I_IN) { const int nb = r % 48, kb = r / 48; p0_transpose_item(P.in[3], IN_COLS, 32 * nb, Win, DM, 32 * nb, 64 * kb, scr, lane); continue; } r -= I_IN;
        if (r < I_IN) { const int nb = r % 48, kb = r / 48; p0_transpose_item(P.in[3], IN_COLS, 1544 + 32 * nb, Win, DM, 1536 + 32 * nb, 64 * kb, scr, lane); continue; } r -= I_IN;
        if (r < I_OUT) { const int nb = r % 32, kb = r / 32; p0_transpose_item(P.in[6], DM, 32 * nb, Wout, DM, 32 * nb, 64 * kb, scr, lane); continue; } r -= I_OUT;
        if (r < I_XQ) { const int nb = r % 8, kb = r / 8; p0_transpose_item(P.in[10], 256, 32 * nb, Wxq, DM, 32 * nb, 64 * kb, scr, lane); continue; } r -= I_XQ;
        if (r < I_XO) { const int nb = r % 32, kb = r / 32; p0_transpose_item(P.in[13], DM, 32 * nb, Wxo, 256, 32 * nb, 64 * kb, scr, lane); continue; } r -= I_XO;
        if (r < I_G) { const int nb = r % 88, kb = r / 88; const int n0 = 32 * nb; p0_transpose_item(P.in[16], DFF, n0, Wgu, DM, (n0 >> 7) * 256 + (n0 & 127), 64 * kb, scr, lane); continue; } r -= I_G;
        if (r < I_G) { const int nb = r % 88, kb = r / 88; const int n0 = 32 * nb; p0_transpose_item(P.in[17], DFF, n0, Wgu, DM, (n0 >> 7) * 256 + 128 + (n0 & 127), 64 * kb, scr, lane); continue; } r -= I_G;
        { const int nb = r % 32, kb = r / 32; p0_transpose_item(P.in[18], DM, 32 * nb, Wdn, DFF, 32 * nb, 64 * kb, scr, lane); }
    }
}

__device__ __forceinline__ void p0_row(const Ptrs& P, int m, const LAS float* wg, int lane) {
    const f32x4* xr = (const f32x4*)(P.in[0] + (size_t)m * DM) + lane;
    const f32x4* gr = (const f32x4*)P.in[2] + lane;
    f32x4 v[4]; float ss = 0.f;
#pragma unroll
    for (int j = 0; j < 4; ++j) { v[j] = xr[64 * j]; ss += (v[j].x * v[j].x + v[j].y * v[j].y) + (v[j].z * v[j].z + v[j].w * v[j].w); }
    const float rstd = 1.0f / sqrtf(wave_sum(ss) * (1.0f / DM) + RMS_EPS);
#pragma unroll
    for (int j = 0; j < 4; ++j) { const f32x4 g = gr[64 * j]; v[j] = v[j] * rstd * g; }
    unsigned long long* o8 = (unsigned long long*)((bf16_t*)(P.ws + WS_H1) + (size_t)m * DM) + lane;
#pragma unroll
    for (int j = 0; j < 4; ++j) o8[64 * j] = (unsigned long long)pk2(v[j].x, v[j].y) | ((unsigned long long)pk2(v[j].z, v[j].w) << 32);
    float gs[8];
#pragma unroll
    for (int c = 0; c < 8; ++c) { float a = 0.f;
#pragma unroll
        for (int j = 0; j < 4; ++j) { const f32x4 w = *(const LAS f32x4*)(wg + c * 1024 + 256 * j + 4 * lane); a += (v[j].x * w.x + v[j].y * w.y) + (v[j].z * w.z + v[j].w * w.w); }
        gs[c] = wave_sum(a); }
    if (lane < 8) {
        float z = 0.f;
#pragma unroll
        for (int c = 0; c < 8; ++c) z = (lane == c) ? gs[c] : z;
        z += P.in[4][lane];
        const float lf = (z >= 0.f) ? -log1pf(expf(-z)) : (z - log1pf(expf(z)));
        ((float*)(P.ws + WS_LOGF))[(size_t)lane * SEQ + m] = lf;
    }
}

__device__ __forceinline__ void p0_memkv_unit(const Ptrs& P, int unit, LAS float* lds, int tid) {
    const int rb = unit >> 4, cb = unit & 15, wave = tid >> 6, lane = tid & 63;
    const float* W = cb < 8 ? P.in[11] : P.in[12]; const int c0 = (cb & 7) * 32;
    bf16_t* Out = (bf16_t*)(P.ws + (cb < 8 ? WS_KMEM : WS_VMEM));
#pragma unroll
    for (int rr = 0; rr < 2; ++rr) { const int r = 2 * wave + rr;
        const f32x4* xr = (const f32x4*)(P.in[1] + (size_t)(16 * rb + r) * DM) + lane; const f32x4* gr = (const f32x4*)P.in[9] + lane;
        f32x4 v[4]; float ss = 0.f;
#pragma unroll
        for (int j = 0; j < 4; ++j) { v[j] = xr[64 * j]; ss += (v[j].x * v[j].x + v[j].y * v[j].y) + (v[j].z * v[j].z + v[j].w * v[j].w); }
        const float rstd = 1.0f / sqrtf(wave_sum(ss) * (1.0f / DM) + RMS_EPS);
#pragma unroll
        for (int j = 0; j < 4; ++j) { const f32x4 g = gr[64 * j]; *(LAS f32x4*)(lds + r * 1024 + 256 * j + 4 * lane) = v[j] * rstd * g; } }
    __syncthreads();
    const int col = lane & 31, kh = lane >> 5, kbase = wave * 128 + kh * 64;
    float acc[16];
#pragma unroll
    for (int r = 0; r < 16; ++r) acc[r] = 0.f;
#pragma unroll 2
    for (int i = 0; i < 64; i += 4) {
        const float w0 = W[(size_t)(kbase + i) * 256 + c0 + col], w1 = W[(size_t)(kbase + i + 1) * 256 + c0 + col];
        const float w2 = W[(size_t)(kbase + i + 2) * 256 + c0 + col], w3 = W[(size_t)(kbase + i + 3) * 256 + c0 + col];
#pragma unroll
        for (int r = 0; r < 16; ++r) { const f32x4 hv = *(const LAS f32x4*)(lds + r * 1024 + kbase + i); acc[r] += (hv.x * w0 + hv.y * w1) + (hv.z * w2 + hv.w * w3); }
    }
    __syncthreads();
#pragma unroll
    for (int r = 0; r < 16; ++r) lds[((wave * 2 + kh) * 16 + r) * 32 + col] = acc[r];
    __syncthreads();
    { float s = 0.f;
#pragma unroll
      for (int p = 0; p < 16; ++p) s += lds[(p * 16 + (tid >> 5)) * 32 + (tid & 31)];
      Out[(size_t)(16 * rb + (tid >> 5)) * 256 + c0 + (tid & 31)] = (bf16_t)f2bf(s); }
    __syncthreads();
}

__device__ __forceinline__ void p0_prologue(const Ptrs& P, LAS unsigned char* ldsb, int vb, int nb) {
    const int tid = threadIdx.x, lane = tid & 63, wave = tid >> 6;
    LAS float* lds = (LAS float*)ldsb;
    for (int u = vb; u < 256; u += nb) p0_memkv_unit(P, u, lds, tid);
    for (int i = vb * 512 + tid; i < 3 * 8 * 129; i += nb * 512) { const int j = i % 129, ph = i / 129, h = ph & 7, p = ph >> 3; const int dil = p == 0 ? 1 : (p == 1 ? 4 : 16);
        ((float*)(P.ws + WS_BTAB))[ph * BT_STRIDE + j] = P.in[5][t5_bucket(j * dil) * 8 + h] * LOG2E; }
    for (int i = tid; i < 8 * 1024; i += 512) { const int k = i >> 3, c = i & 7; lds[c * 1024 + k] = P.in[3][(size_t)k * IN_COLS + 1536 + c]; }
    __syncthreads();
    const int gw = vb * 8 + wave, ngw = nb * 8;
    for (int m = gw; m < SEQ; m += ngw) p0_row(P, m, lds, lane);
    p0_weights(P, lds + 8192 + wave * (64 * 33), gw, ngw, lane);
}

constexpr int P0_LDS = 65536 + 8 * 64 * 33 * 4;

__global__ void __launch_bounds__(512) k_p0(Ptrs P) {
    extern __shared__ __attribute__((aligned(16))) unsigned char lds_raw[];
    p0_prologue(P, (LAS unsigned char*)lds_raw, blockIdx.x, gridDim.x);
}

__device__ __forceinline__ void cumsum_head(const Ptrs& P, int h, LAS unsigned char* ldsb) {
    const int tid = threadIdx.x;
    LAS double* sd = (LAS double*)ldsb;
    const float* lf = (const float*)(P.ws + WS_LOGF) + (size_t)h * SEQ + tid * 32;
    float* cc = (float*)(P.ws + WS_C) + (size_t)h * SEQ + tid * 32;
    f32x4 v[8]; double s = 0.0;
#pragma unroll
    for (int i = 0; i < 8; ++i) { v[i] = ((const f32x4*)lf)[i]; s += (double)v[i].x + (double)v[i].y + (double)v[i].z + (double)v[i].w; }
    sd[tid] = s;
    __syncthreads();
    for (int off = 1; off < 512; off <<= 1) { double t = (tid >= off) ? sd[tid - off] : 0.0; __syncthreads(); sd[tid] += t; __syncthreads(); }
    double run = (tid > 0) ? sd[tid - 1] : 0.0;
#pragma unroll
    for (int i = 0; i < 8; ++i) { f32x4 o; run += (double)v[i].x; o.x = (float)run; run += (double)v[i].y; o.y = (float)run; run += (double)v[i].z; o.z = (float)run; run += (double)v[i].w; o.w = (float)run; ((f32x4*)cc)[i] = o; }
    __syncthreads();
}
__global__ void __launch_bounds__(512) k_cumsum(Ptrs P) {
    __shared__ __attribute__((aligned(16))) double sd[512];
    cumsum_head(P, blockIdx.x, (LAS unsigned char*)sd);
}

struct GemmArgs { const bf16_t* A; const bf16_t* Bt; void* O; int K; int ld; float sc; int pad; };
template <int MODE  >
__global__ void __launch_bounds__(256) k_gemm(GemmArgs g) {
    const bf16_t* A = g.A; const bf16_t* Bt = g.Bt; const int K = g.K;
    const int wave = threadIdx.x >> 6, lane = threadIdx.x & 63, r = lane & 15, q = lane >> 4;
    const int row0 = blockIdx.y * 64 + (wave >> 1) * 32, col0 = blockIdx.x * 64 + (wave & 1) * 32;
    f32x4 acc[2][2];
#pragma unroll
    for (int i = 0; i < 2; ++i)
#pragma unroll
        for (int j = 0; j < 2; ++j) acc[i][j] = (f32x4){0.f, 0.f, 0.f, 0.f};
    for (int k0 = 0; k0 < K; k0 += 32) {
        bf16x8 a[2], b[2];
#pragma unroll
        for (int i = 0; i < 2; ++i) { a[i] = *(const bf16x8*)(A + (size_t)(row0 + 16 * i + r) * K + k0 + q * 8); b[i] = *(const bf16x8*)(Bt + (size_t)(col0 + 16 * i + r) * K + k0 + q * 8); }
#pragma unroll
        for (int i = 0; i < 2; ++i)
#pragma unroll
            for (int j = 0; j < 2; ++j) acc[i][j] = __builtin_amdgcn_mfma_f32_16x16x32_bf16(a[i], b[j], acc[i][j], 0, 0, 0);
    }
#pragma unroll
    for (int i = 0; i < 2; ++i)
#pragma unroll
        for (int j = 0; j < 2; ++j)
#pragma unroll
            for (int e = 0; e < 4; ++e) { const int rr = row0 + 16 * i + q * 4 + e, c = col0 + 16 * j + r; const float v = acc[i][j][e];
                if (MODE == 0) { const bool isq = (c < 512) || (c >= 1536 && c < 2048); ((bf16_t*)g.O)[(size_t)rr * NQKV + c] = (bf16_t)f2bf(isq ? v * C2 : v); }
                else if (MODE == 1) ((float*)g.O)[(size_t)rr * g.ld + c] = v;
                else ((bf16_t*)g.O)[(size_t)rr * g.ld + c] = (bf16_t)f2bf(v * g.sc); }
}
__global__ void __launch_bounds__(256) k_gemm_swiglu(const bf16_t* A, const bf16_t* Wgu, bf16_t* H) {
    const int K = DM;
    const int wave = threadIdx.x >> 6, lane = threadIdx.x & 63, r = lane & 15, q = lane >> 4;
    const int row0 = blockIdx.y * 64 + (wave >> 1) * 32, col0 = blockIdx.x * 64 + (wave & 1) * 32;
    const int wrow0 = (col0 >> 7) * 256 + (col0 & 127);
    f32x4 ag[2][2], au[2][2];
#pragma unroll
    for (int i = 0; i < 2; ++i)
#pragma unroll
        for (int j = 0; j < 2; ++j) { ag[i][j] = (f32x4){0.f, 0.f, 0.f, 0.f}; au[i][j] = (f32x4){0.f, 0.f, 0.f, 0.f}; }
    for (int k0 = 0; k0 < K; k0 += 32) {
        bf16x8 a[2], bg[2], bu[2];
#pragma unroll
        for (int i = 0; i < 2; ++i) { a[i] = *(const bf16x8*)(A + (size_t)(row0 + 16 * i + r) * K + k0 + q * 8);
            bg[i] = *(const bf16x8*)(Wgu + (size_t)(wrow0 + 16 * i + r) * K + k0 + q * 8); bu[i] = *(const bf16x8*)(Wgu + (size_t)(wrow0 + 128 + 16 * i + r) * K + k0 + q * 8); }
#pragma unroll
        for (int i = 0; i < 2; ++i)
#pragma unroll
            for (int j = 0; j < 2; ++j) { ag[i][j] = __builtin_amdgcn_mfma_f32_16x16x32_bf16(a[i], bg[j], ag[i][j], 0, 0, 0); au[i][j] = __builtin_amdgcn_mfma_f32_16x16x32_bf16(a[i], bu[j], au[i][j], 0, 0, 0); }
    }
#pragma unroll
    for (int i = 0; i < 2; ++i)
#pragma unroll
        for (int j = 0; j < 2; ++j)
#pragma unroll
            for (int e = 0; e < 4; ++e) { const float g = ag[i][j][e], u = au[i][j][e]; const float s = g / (1.0f + __expf(-g));
                H[(size_t)(row0 + 16 * i + q * 4 + e) * DFF + col0 + 16 * j + r] = (bf16_t)f2bf(s * u); }
}

__global__ void __launch_bounds__(256) k_norm_res(const float* y, const float* base, const float* g1, float* out, const float* g2, bf16_t* hn) {
    const int lane = threadIdx.x & 63; const int m = blockIdx.x * 4 + (threadIdx.x >> 6);
    const f32x4* yr = (const f32x4*)(y + (size_t)m * DM) + lane; const f32x4* br = (const f32x4*)(base + (size_t)m * DM) + lane;
    f32x4 v[4]; float ss = 0.f;
#pragma unroll
    for (int j = 0; j < 4; ++j) { v[j] = yr[64 * j]; ss += (v[j].x * v[j].x + v[j].y * v[j].y) + (v[j].z * v[j].z + v[j].w * v[j].w); }
    const float rstd = 1.0f / sqrtf(wave_sum(ss) * (1.0f / DM) + RMS_EPS);
    float s2 = 0.f;
#pragma unroll
    for (int j = 0; j < 4; ++j) { const f32x4 g = ((const f32x4*)g1 + lane)[64 * j]; v[j] = br[64 * j] + v[j] * rstd * g; s2 += (v[j].x * v[j].x + v[j].y * v[j].y) + (v[j].z * v[j].z + v[j].w * v[j].w); }
    f32x4* orow = (f32x4*)(out + (size_t)m * DM) + lane;
#pragma unroll
    for (int j = 0; j < 4; ++j) orow[64 * j] = v[j];
    if (hn) {
        const float r2 = 1.0f / sqrtf(wave_sum(s2) * (1.0f / DM) + RMS_EPS);
        unsigned long long* o8 = (unsigned long long*)(hn + (size_t)m * DM) + lane;
#pragma unroll
        for (int j = 0; j < 4; ++j) { const f32x4 g = ((const f32x4*)g2 + lane)[64 * j]; const f32x4 w = v[j] * r2 * g; o8[64 * j] = (unsigned long long)pk2(w.x, w.y) | ((unsigned long long)pk2(w.z, w.w) << 32); }
    }
}

struct RowAttn {
    float q[64], o[64], m, l;
    __device__ __forceinline__ void init(const bf16_t* qp) {
#pragma unroll
        for (int d = 0; d < 64; ++d) { q[d] = bf2f(qp[d]); o[d] = 0.f; } m = -INFINITY; l = 0.f; }
    __device__ __forceinline__ void key(const bf16_t* kp, const bf16_t* vp, float bias) {
        float s = 0.f;
#pragma unroll
        for (int d = 0; d < 64; d += 8) { const u32x4 kv = *(const u32x4*)(kp + d);
            s += q[d] * __uint_as_float(kv.x << 16) + q[d + 1] * __uint_as_float(kv.x & 0xffff0000u) + q[d + 2] * __uint_as_float(kv.y << 16) + q[d + 3] * __uint_as_float(kv.y & 0xffff0000u)
               + q[d + 4] * __uint_as_float(kv.z << 16) + q[d + 5] * __uint_as_float(kv.z & 0xffff0000u) + q[d + 6] * __uint_as_float(kv.w << 16) + q[d + 7] * __uint_as_float(kv.w & 0xffff0000u); }
        s += bias;
        const float mnew = fmaxf(m, s), alpha = exp2f(m - mnew), p = exp2f(s - mnew);
        l = l * alpha + p; m = mnew;
#pragma unroll
        for (int d = 0; d < 64; d += 8) { const u32x4 vv = *(const u32x4*)(vp + d);
            o[d] = o[d] * alpha + p * __uint_as_float(vv.x << 16); o[d + 1] = o[d + 1] * alpha + p * __uint_as_float(vv.x & 0xffff0000u);
            o[d + 2] = o[d + 2] * alpha + p * __uint_as_float(vv.y << 16); o[d + 3] = o[d + 3] * alpha + p * __uint_as_float(vv.y & 0xffff0000u);
            o[d + 4] = o[d + 4] * alpha + p * __uint_as_float(vv.z << 16); o[d + 5] = o[d + 5] * alpha + p * __uint_as_float(vv.z & 0xffff0000u);
            o[d + 6] = o[d + 6] * alpha + p * __uint_as_float(vv.w << 16); o[d + 7] = o[d + 7] * alpha + p * __uint_as_float(vv.w & 0xffff0000u); }
    }
    __device__ __forceinline__ void store(bf16_t* op) const { const float rl = 1.0f / l;
#pragma unroll
        for (int d = 0; d < 64; d += 2) *(unsigned*)(op + d) = pk2(o[d] * rl, o[d + 1] * rl); }
};
__global__ void __launch_bounds__(128) k_fox_naive(const bf16_t* QKV, const float* cc, bf16_t* O) {
    const int h = blockIdx.y, qb = (int)gridDim.x - 1 - (int)blockIdx.x, t = qb * 128 + threadIdx.x;
    RowAttn ra; ra.init(QKV + (size_t)t * NQKV + h * 64);
    const float* ch = cc + (size_t)h * SEQ; const float ct = ch[t];
    const int tlast = (t | 63);
    for (int s = 0; s <= tlast; ++s) { const float bias = (s <= t) ? (ct - ch[s]) * LOG2E : -INFINITY;
        ra.key(QKV + (size_t)s * NQKV + 512 + h * 64, QKV + (size_t)s * NQKV + 1024 + h * 64, bias); }
    ra.store(O + (size_t)t * DM + h * 64);
}
__global__ void __launch_bounds__(128) k_dil_naive(const bf16_t* QKV, const float* btab, bf16_t* O) {
    const int h = blockIdx.y, t = blockIdx.x * 128 + threadIdx.x;
    RowAttn ra; ra.init(QKV + (size_t)t * NQKV + 1536 + h * 64);
    for (int p = 0; p < 3; ++p) { const int dil = p == 0 ? 1 : (p == 1 ? 4 : 16); const float* bt = btab + (p * 8 + h) * BT_STRIDE;
        for (int j = 0; j <= 128; ++j) { const int s = t - j * dil; if (s < 0) break;
            ra.key(QKV + (size_t)s * NQKV + 2048 + h * 64, QKV + (size_t)s * NQKV + 2560 + h * 64, bt[j]); } }
    ra.store(O + (size_t)t * DM + 512 + h * 64);
}
__global__ void __launch_bounds__(128) k_xattn_naive(const bf16_t* QX, const bf16_t* Kmem, const bf16_t* Vmem, bf16_t* OX) {
    const int h = blockIdx.y, t = blockIdx.x * 128 + threadIdx.x;
    RowAttn ra; ra.init(QX + (size_t)t * 256 + h * 64);
    for (int s = 0; s < NMEM; ++s) ra.key(Kmem + (size_t)s * 256 + h * 64, Vmem + (size_t)s * 256 + h * 64, 0.f);
    ra.store(OX + (size_t)t * 256 + h * 64);
}

extern "C" void kernel_launch(void* const* d_in, const int* in_sizes, int n_in, void* d_out, int out_size, void* d_ws, size_t ws_size, hipStream_t stream) {
    static int inited = 0;
    if (!inited) {
        if (n_in != 20 || out_size != SEQ * DM || ws_size < WS_END) { fprintf(stderr, "kernel_launch: unexpected problem (n_in %d out %d ws %zu)\n", n_in, out_size, ws_size); inited = -1; return; }
        if (hipFuncSetAttribute((const void*)k_p0, hipFuncAttributeMaxDynamicSharedMemorySize, P0_LDS) != hipSuccess) { fprintf(stderr, "kernel_launch: hipFuncSetAttribute failed\n"); inited = -1; return; }
        inited = 1;
    }
    if (inited < 0) return;
    Ptrs P{};
    for (int i = 0; i < 20; ++i) P.in[i] = (const float*)d_in[i];
    P.out = (float*)d_out; P.ws = (unsigned char*)d_ws;
    unsigned char* ws = (unsigned char*)d_ws;
    bf16_t* Win = (bf16_t*)(ws + WS_WIN); bf16_t* Wout = (bf16_t*)(ws + WS_WOUT); bf16_t* Wxq = (bf16_t*)(ws + WS_WXQ); bf16_t* Wxo = (bf16_t*)(ws + WS_WXO);
    bf16_t* Wgu = (bf16_t*)(ws + WS_WGU); bf16_t* Wdn = (bf16_t*)(ws + WS_WDN);
    bf16_t* QKV = (bf16_t*)(ws + WS_QKV); bf16_t* QX = (bf16_t*)(ws + WS_QX); bf16_t* OX = (bf16_t*)(ws + WS_OX); bf16_t* HMID = (bf16_t*)(ws + WS_HMID);
    bf16_t* H1 = (bf16_t*)(ws + WS_H1); bf16_t* H3 = (bf16_t*)(ws + WS_H3); bf16_t* O = (bf16_t*)(ws + WS_O); bf16_t* H2 = (bf16_t*)(ws + WS_H2);
    float* Y = (float*)(ws + WS_Y); float* CC = (float*)(ws + WS_C); float* BT = (float*)(ws + WS_BTAB);
    bf16_t* KM = (bf16_t*)(ws + WS_KMEM); bf16_t* VM = (bf16_t*)(ws + WS_VMEM);
    float* out = (float*)d_out;
    auto mk = [](const bf16_t* A, const bf16_t* Bt, void* O, int K, int ld, float sc) { GemmArgs g{}; g.A = A; g.Bt = Bt; g.O = O; g.K = K; g.ld = ld; g.sc = sc; g.pad = 0; return g; };

    hipLaunchKernelGGL(k_p0, dim3(256), dim3(512), P0_LDS, stream, P);
    hipLaunchKernelGGL(k_cumsum, dim3(8), dim3(512), 0, stream, P);
    hipLaunchKernelGGL(k_gemm<0>, dim3(NQKV / 64, SEQ / 64), dim3(256), 0, stream, mk(H1, Win, QKV, DM, NQKV, 1.f));
    hipLaunchKernelGGL(k_fox_naive, dim3(SEQ / 128, 8), dim3(128), 0, stream, QKV, CC, O);
    hipLaunchKernelGGL(k_dil_naive, dim3(SEQ / 128, 8), dim3(128), 0, stream, QKV, BT, O);
    hipLaunchKernelGGL(k_gemm<1>, dim3(DM / 64, SEQ / 64), dim3(256), 0, stream, mk(O, Wout, Y, DM, DM, 1.f));
    hipLaunchKernelGGL(k_norm_res, dim3(SEQ / 4), dim3(256), 0, stream, Y, P.in[0], P.in[7], out, P.in[8], H2);
    hipLaunchKernelGGL(k_gemm<2>, dim3(256 / 64, SEQ / 64), dim3(256), 0, stream, mk(H2, Wxq, QX, DM, 256, C2));
    hipLaunchKernelGGL(k_xattn_naive, dim3(SEQ / 128, 4), dim3(128), 0, stream, QX, KM, VM, OX);
    hipLaunchKernelGGL(k_gemm<1>, dim3(DM / 64, SEQ / 64), dim3(256), 0, stream, mk(OX, Wxo, Y, 256, DM, 1.f));
    hipLaunchKernelGGL(k_norm_res, dim3(SEQ / 4), dim3(256), 0, stream, Y, out, P.in[14], out, P.in[15], H3);
    hipLaunchKernelGGL(k_gemm_swiglu, dim3(DFF / 64, SEQ / 64), dim3(256), 0, stream, H3, Wgu, HMID);
    hipLaunchKernelGGL(k_gemm<1>, dim3(DM / 64, SEQ / 64), dim3(256), 0, stream, mk(HMID, Wdn, Y, DFF, DM, 1.f));
    hipLaunchKernelGGL(k_norm_res, dim3(SEQ / 4), dim3(256), 0, stream, Y, out, P.in[19], out, (const float*)nullptr, (bf16_t*)nullptr);
}
```

```cpp
#include <hip/hip_runtime.h>
#include <cstdint>
#include <cstdio>

#define LAS __attribute__((address_space(3)))
typedef unsigned short bf16_t;
typedef short bf16x8 __attribute__((ext_vector_type(8)));
typedef float f32x4 __attribute__((ext_vector_type(4)));
typedef float f32x16 __attribute__((ext_vector_type(16)));
typedef unsigned u32x4 __attribute__((ext_vector_type(4)));
typedef unsigned u32x2 __attribute__((ext_vector_type(2)));

constexpr int SEQ = 16384, DM = 1024, NMEM = 256, DFF = 2816;
constexpr int IN_COLS = 3080;
constexpr int NQKV = 3072;
constexpr int NGU = 2 * DFF;
constexpr float RMS_EPS = 1e-6f;
constexpr float LOG2E = 1.4426950408889634f;
constexpr float C2 = 0.125f * LOG2E;
constexpr int BT_STRIDE = 132;

constexpr size_t MiB = 1u << 20;
constexpr size_t WS_CTL = 0;
constexpr size_t WS_WIN = 1 * MiB;
constexpr size_t WS_WOUT = 7 * MiB;
constexpr size_t WS_WXQ = 9 * MiB;
constexpr size_t WS_WXO = 9 * MiB + 512 * 1024;
constexpr size_t WS_WGU = 10 * MiB;
constexpr size_t WS_WDN = 21 * MiB;
constexpr size_t WS_QKV = 28 * MiB;
constexpr size_t WS_QX = 28 * MiB;
constexpr size_t WS_OX = 36 * MiB;
constexpr size_t WS_HMID = 28 * MiB;
constexpr size_t WS_H1 = 124 * MiB;
constexpr size_t WS_H3 = 124 * MiB;
constexpr size_t WS_O = 156 * MiB;
constexpr size_t WS_H2 = 156 * MiB;
constexpr size_t WS_Y = 188 * MiB;
constexpr size_t WS_LOGF = 252 * MiB;
constexpr size_t WS_C = 252 * MiB + 512 * 1024;
constexpr size_t WS_KMEM = 253 * MiB;
constexpr size_t WS_VMEM = 253 * MiB + 128 * 1024;
constexpr size_t WS_BTAB = 253 * MiB + 256 * 1024;
constexpr size_t WS_END = 256 * MiB;

__device__ __forceinline__ unsigned f2bf(float f) { unsigned u = __float_as_uint(f); return (u + 0x7fffu + ((u >> 16) & 1u)) >> 16; }
__device__ __forceinline__ unsigned pk2(float lo, float hi) { return f2bf(lo) | (f2bf(hi) << 16); }
__device__ __forceinline__ float bf2f(bf16_t b) { return __uint_as_float(((unsigned)b) << 16); }
__device__ __forceinline__ float wave_sum(float v) {
#pragma unroll
    for (int o = 1; o < 64; o <<= 1) v += __shfl_xor(v, o);
    return v;
}
__device__ __forceinline__ int t5_bucket(int dist) {
    if (dist < 16) return dist;
    int b = 16;
    b += dist >= 22; b += dist >= 30; b += dist >= 40; b += dist >= 54; b += dist >= 73; b += dist >= 99; b += dist >= 134; b += dist >= 182;
    b += dist >= 246; b += dist >= 332; b += dist >= 450; b += dist >= 609; b += dist >= 825; b += dist >= 1117; b += dist >= 1513;
    return b;
}

struct Ptrs {
    const float* in[20];
    float* out;
    unsigned char* ws;
};

__device__ __forceinline__ void p0_transpose_item(const float* W, int ldw, int scol0, bf16_t* WT, int ldt, int drow0, int k0, LAS float* scr, int lane) {
#pragma unroll 8
    for (int i = 0; i < 32; ++i) { const int kk = 2 * i + (lane >> 5); scr[kk * 33 + (lane & 31)] = W[(size_t)(k0 + kk) * ldw + scol0 + (lane & 31)]; }
    asm volatile("s_waitcnt lgkmcnt(0)" ::: "memory");
    const int c = lane & 7;
#pragma unroll
    for (int j = 0; j < 4; ++j) { const int n = (lane >> 3) + 8 * j; const LAS float* s = scr + (8 * c) * 33 + n;
        u32x4 o; o.x = pk2(s[0 * 33], s[1 * 33]); o.y = pk2(s[2 * 33], s[3 * 33]); o.z = pk2(s[4 * 33], s[5 * 33]); o.w = pk2(s[6 * 33], s[7 * 33]);
        *(u32x4*)(WT + (size_t)(drow0 + n) * ldt + k0 + 8 * c) = o; }
    asm volatile("s_waitcnt lgkmcnt(0)" ::: "memory");
}

__device__ __forceinline__ void p0_weights(const Ptrs& P, LAS float* scr, int gw, int ngw, int lane) {
    unsigned char* ws = P.ws;
    bf16_t* Win = (bf16_t*)(ws + WS_WIN); bf16_t* Wout = (bf16_t*)(ws + WS_WOUT); bf16_t* Wxq = (bf16_t*)(ws + WS_WXQ); bf16_t* Wxo = (bf16_t*)(ws + WS_WXO);
    bf16_t* Wgu = (bf16_t*)(ws + WS_WGU); bf16_t* Wdn = (bf16_t*)(ws + WS_WDN);
    constexpr int I_IN = (DM / 64) * (1536 / 32);
    constexpr int I_OUT = (DM / 64) * (DM / 32);
    constexpr int I_XQ = (DM / 64) * (256 / 32);
    constexpr int I_XO = (256 / 64) * (DM / 32);
    constexpr int I_G = (DM / 64) * (DFF / 32);
    constexpr int I_DN = (DFF / 64) * (DM / 32);
    constexpr int NITEMS = 2 * I_IN + I_OUT + I_XQ + I_XO + 2 * I_G + I_DN;
    for (int it = gw; it < NITEMS; it += ngw) {
        int r = it;
        if (r < I_IN) { const int nb = r % 48, kb = r / 48; p0_transpose_item(P.in[3], IN_COLS, 32 * nb, Win, DM, 32 * nb, 64 * kb, scr, lane); continue; } r -= I_IN;
        if (r < I_IN) { const int nb = r % 48, kb = r / 48; p0_transpose_item(P.in[3], IN_COLS, 1544 + 32 * nb, Win, DM, 1536 + 32 * nb, 64 * kb, scr, lane); continue; } r -= I_IN;
        if (r < I_OUT) { const int nb = r % 32, kb = r / 32; p0_transpose_item(P.in[6], DM, 32 * nb, Wout, DM, 32 * nb, 64 * kb, scr, lane); continue; } r -= I_OUT;
        if (r < I_XQ) { const int nb = r % 8, kb = r / 8; p0_transpose_item(P.in[10], 256, 32 * nb, Wxq, DM, 32 * nb, 64 * kb, scr, lane); continue; } r -= I_XQ;
        if (r < I_XO) { const int nb = r % 32, kb = r / 32; p0_transpose_item(P.in[13], DM, 32 * nb, Wxo, 256, 32 * nb, 64 * kb, scr, lane); continue; } r -= I_XO;
        if (r < I_G) { const int nb = r % 88, kb = r / 88; const int n0 = 32 * nb; p0_transpose_item(P.in[16], DFF, n0, Wgu, DM, (n0 >> 7) * 256 + (n0 & 127), 64 * kb, scr, lane); continue; } r -= I_G;
        if (r < I_G) { const int nb = r % 88, kb = r / 88; const int n0 = 32 * nb; p0_transpose_item(P.in[17], DFF, n0, Wgu, DM, (n0 >> 7) * 256 + 128 + (n0 & 127), 64 * kb, scr, lane); continue; } r -= I_G;
        { const int nb = r % 32, kb = r / 32; p0_transpose_item(P.in[18], DM, 32 * nb, Wdn, DFF, 32 * nb, 64 * kb, scr, lane); }
    }
}

__device__ __forceinline__ void p0_row(const Ptrs& P, int m, const LAS float* wg, int lane) {
    const f32x4* xr = (const f32x4*)(P.in[0] + (size_t)m * DM) + lane;
    const f32x4* gr = (const f32x4*)P.in[2] + lane;
    f32x4 v[4]; float ss = 0.f;
#pragma unroll
    for (int j = 0; j < 4; ++j) { v[j] = xr[64 * j]; ss += (v[j].x * v[j].x + v[j].y * v[j].y) + (v[j].z * v[j].z + v[j].w * v[j].w); }
    const float rstd = 1.0f / sqrtf(wave_sum(ss) * (1.0f / DM) + RMS_EPS);
#pragma unroll
    for (int j = 0; j < 4; ++j) { const f32x4 g = gr[64 * j]; v[j] = v[j] * rstd * g; }
    unsigned long long* o8 = (unsigned long long*)((bf16_t*)(P.ws + WS_H1) + (size_t)m * DM) + lane;
#pragma unroll
    for (int j = 0; j < 4; ++j) o8[64 * j] = (unsigned long long)pk2(v[j].x, v[j].y) | ((unsigned long long)pk2(v[j].z, v[j].w) << 32);
    float gs[8];
#pragma unroll
    for (int c = 0; c < 8; ++c) { float a = 0.f;
#pragma unroll
        for (int j = 0; j < 4; ++j) { const f32x4 w = *(const LAS f32x4*)(wg + c * 1024 + 256 * j + 4 * lane); a += (v[j].x * w.x + v[j].y * w.y) + (v[j].z * w.z + v[j].w * w.w); }
        gs[c] = wave_sum(a); }
    if (lane < 8) {
        float z = 0.f;
#pragma unroll
        for (int c = 0; c < 8; ++c) z = (lane == c) ? gs[c] : z;
        z += P.in[4][lane];
        const float lf = (z >= 0.f) ? -log1pf(expf(-z)) : (z - log1pf(expf(z)));
        ((float*)(P.ws + WS_LOGF))[(size_t)lane * SEQ + m] = lf;
    }
}

__device__ __forceinline__ void p0_memkv_unit(const Ptrs& P, int unit, LAS float* lds, int tid) {
    const int rb = unit >> 4, cb = unit & 15, wave = tid >> 6, lane = tid & 63;
    const float* W = cb < 8 ? P.in[11] : P.in[12]; const int c0 = (cb & 7) * 32;
    bf16_t* Out = (bf16_t*)(P.ws + (cb < 8 ? WS_KMEM : WS_VMEM));
#pragma unroll
    for (int rr = 0; rr < 2; ++rr) { const int r = 2 * wave + rr;
        const f32x4* xr = (const f32x4*)(P.in[1] + (size_t)(16 * rb + r) * DM) + lane; const f32x4* gr = (const f32x4*)P.in[9] + lane;
        f32x4 v[4]; float ss = 0.f;
#pragma unroll
        for (int j = 0; j < 4; ++j) { v[j] = xr[64 * j]; ss += (v[j].x * v[j].x + v[j].y * v[j].y) + (v[j].z * v[j].z + v[j].w * v[j].w); }
        const float rstd = 1.0f / sqrtf(wave_sum(ss) * (1.0f / DM) + RMS_EPS);
#pragma unroll
        for (int j = 0; j < 4; ++j) { const f32x4 g = gr[64 * j]; *(LAS f32x4*)(lds + r * 1024 + 256 * j + 4 * lane) = v[j] * rstd * g; } }
    __syncthreads();
    const int col = lane & 31, kh = lane >> 5, kbase = wave * 128 + kh * 64;
    float acc[16];
#pragma unroll
    for (int r = 0; r < 16; ++r) acc[r] = 0.f;
#pragma unroll 2
    for (int i = 0; i < 64; i += 4) {
        const float w0 = W[(size_t)(kbase + i) * 256 + c0 + col], w1 = W[(size_t)(kbase + i + 1) * 256 + c0 + col];
        const float w2 = W[(size_t)(kbase + i + 2) * 256 + c0 + col], w3 = W[(size_t)(kbase + i + 3) * 256 + c0 + col];
#pragma unroll
        for (int r = 0; r < 16; ++r) { const f32x4 hv = *(const LAS f32x4*)(lds + r * 1024 + kbase + i); acc[r] += (hv.x * w0 + hv.y * w1) + (hv.z * w2 + hv.w * w3); }
    }
    __syncthreads();
#pragma unroll
    for (int r = 0; r < 16; ++r) lds[((wave * 2 + kh) * 16 + r) * 32 + col] = acc[r];
    __syncthreads();
    { float s = 0.f;
#pragma unroll
      for (int p = 0; p < 16; ++p) s += lds[(p * 16 + (tid >> 5)) * 32 + (tid & 31)];
      Out[(size_t)(16 * rb + (tid >> 5)) * 256 + c0 + (tid & 31)] = (bf16_t)f2bf(s); }
    __syncthreads();
}

__device__ __forceinline__ void p0_prologue(const Ptrs& P, LAS unsigned char* ldsb, int vb, int nb) {
    const int tid = threadIdx.x, lane = tid & 63, wave = tid >> 6;
    LAS float* lds = (LAS float*)ldsb;
    for (int u = vb; u < 256; u += nb) p0_memkv_unit(P, u, lds, tid);
    for (int i = vb * 512 + tid; i < 3 * 8 * 129; i += nb * 512) { const int j = i % 129, ph = i / 129, h = ph & 7, p = ph >> 3; const int dil = p == 0 ? 1 : (p == 1 ? 4 : 16);
        ((float*)(P.ws + WS_BTAB))[ph * BT_STRIDE + j] = P.in[5][t5_bucket(j * dil) * 8 + h] * LOG2E; }
    for (int i = tid; i < 8 * 1024; i += 512) { const int k = i >> 3, c = i & 7; lds[c * 1024 + k] = P.in[3][(size_t)k * IN_COLS + 1536 + c]; }
    __syncthreads();
    const int gw = vb * 8 + wave, ngw = nb * 8;
    for (int m = gw; m < SEQ; m += ngw) p0_row(P, m, lds, lane);
    p0_weights(P, lds + 8192 + wave * (64 * 33), gw, ngw, lane);
}

constexpr int P0_LDS = 65536 + 8 * 64 * 33 * 4;


__device__ __forceinline__ void cumsum_head(const Ptrs& P, int h, LAS unsigned char* ldsb) {
    const int tid = threadIdx.x;
    LAS double* sd = (LAS double*)ldsb;
    const float* lf = (const float*)(P.ws + WS_LOGF) + (size_t)h * SEQ + tid * 32;
    float* cc = (float*)(P.ws + WS_C) + (size_t)h * SEQ + tid * 32;
    f32x4 v[8]; double s = 0.0;
#pragma unroll
    for (int i = 0; i < 8; ++i) { v[i] = ((const f32x4*)lf)[i]; s += (double)v[i].x + (double)v[i].y + (double)v[i].z + (double)v[i].w; }
    sd[tid] = s;
    __syncthreads();
    for (int off = 1; off < 512; off <<= 1) { double t = (tid >= off) ? sd[tid - off] : 0.0; __syncthreads(); sd[tid] += t; __syncthreads(); }
    double run = (tid > 0) ? sd[tid - 1] : 0.0;
#pragma unroll
    for (int i = 0; i < 8; ++i) { f32x4 o; run += (double)v[i].x; o.x = (float)run; run += (double)v[i].y; o.y = (float)run; run += (double)v[i].z; o.z = (float)run; run += (double)v[i].w; o.w = (float)run; ((f32x4*)cc)[i] = o; }
    __syncthreads();
}


namespace pg8 {
#define PG8_LAS __attribute__((address_space(3)))
typedef unsigned short bf16_t;
typedef short bf16x8 __attribute__((ext_vector_type(8)));
typedef float f32x4 __attribute__((ext_vector_type(4)));
typedef unsigned u32x4 __attribute__((ext_vector_type(4)));
constexpr int BM = 256, BK = 64, HALF = 128, HTB = HALF * BK * 2  , STAGE_BYTES = 8 * HTB, NXCD = 8, WGM = 8;

__host__ __device__ __forceinline__ int lds_byte(int r, int c) { const int st = (r >> 4) * 2 + (c >> 5), rr = r & 15, cc = c & 31, ob = rr * 64 + cc * 2; return st * 1024 + (ob ^ (((ob >> 9) & 1) << 5)); }
__host__ __device__ __forceinline__ void stage_rc(int b, int& R, int& C) { const int st = b / 1024, sb = b % 1024, swz = sb ^ (((sb >> 9) & 1) << 5); R = (st >> 1) * 16 + swz / 64; C = (st & 1) * 32 + (swz % 64) / 2; }
__host__ __device__ __forceinline__ int perm32(int rho) { const int n = rho >> 4, i = rho & 15; return 8 * (i >> 2) + 4 * n + (i & 3); }

struct Unit { int pm, pn; };
struct Gemm { const bf16_t* A; const bf16_t* Bt; int M, N, K; };

struct StaticOrder {
    int nM, nN, nwg, G, c;
    __host__ __device__ void init(int M, int N, int G_, int c_) { nM = M / BM; nN = N / BM; nwg = nM * nN; G = G_; c = c_; }
    __host__ __device__ bool next(int i, Unit& u) const {
        const long L = (long)i * G + c; if (L >= nwg) return false;
        int wgid = (int)L; { const int q = nwg / NXCD, r = nwg % NXCD, xcd = wgid % NXCD, off = wgid / NXCD; wgid = (xcd < r ? xcd * (q + 1) : r * (q + 1) + (xcd - r) * q) + off; }
        const int nig = WGM * nN, gid = wgid / nig, fm = gid * WGM, gsz = (nM - fm) < WGM ? (nM - fm) : WGM;
        u.pm = fm + ((wgid % nig) % gsz); u.pn = (wgid % nig) / gsz; return true;
    }
    __device__ __forceinline__ void a_ready(const Unit&) const {}
    __device__ __forceinline__ void done(const Unit&) const {}
};

__device__ __forceinline__ unsigned cvt_pk_bf16(float lo, float hi) { unsigned r; asm volatile("v_cvt_pk_bf16_f32 %0, %1, %2" : "=v"(r) : "v"(lo), "v"(hi)); return r; }
typedef float f32x2 __attribute__((ext_vector_type(2)));
struct EpiQKVp {
    static constexpr bool PERM = true, AFTER_DRAIN = false;
    bf16_t* O;
    __device__ __forceinline__ void operator()(const f32x4 (&acc)[2][2][4][2], const Unit& u, int wr, int wc, int fr, int fq) const {
        const int row0 = u.pm * BM + wr * 64 + fr, col0 = u.pn * BM + wc * 32 + 8 * fq;
        const float sc = (u.pn < 2 || u.pn == 6 || u.pn == 7) ? C2 : 1.f;
#pragma unroll
        for (int ai = 0; ai < 2; ++ai)
#pragma unroll
            for (int m = 0; m < 4; ++m) { bf16_t* rowp = O + (size_t)(row0 + ai * HALF + m * 16) * NQKV + col0;
#pragma unroll
                for (int bj = 0; bj < 2; ++bj) { const f32x4 v0 = acc[ai][bj][m][0] * sc, v1 = acc[ai][bj][m][1] * sc;
                    u32x4 w; w.x = cvt_pk_bf16(v0[0], v0[1]); w.y = cvt_pk_bf16(v0[2], v0[3]); w.z = cvt_pk_bf16(v1[0], v1[1]); w.w = cvt_pk_bf16(v1[2], v1[3]);
                    *(u32x4*)(rowp + bj * HALF) = w; } }
    }
};
struct EpiBfp {
    static constexpr bool PERM = true, AFTER_DRAIN = false;
    bf16_t* O; int ldc; float sc;
    __device__ __forceinline__ void operator()(const f32x4 (&acc)[2][2][4][2], const Unit& u, int wr, int wc, int fr, int fq) const {
        const int row0 = u.pm * BM + wr * 64 + fr, col0 = u.pn * BM + wc * 32 + 8 * fq;
#pragma unroll
        for (int ai = 0; ai < 2; ++ai)
#pragma unroll
            for (int m = 0; m < 4; ++m) { bf16_t* rowp = O + (size_t)(row0 + ai * HALF + m * 16) * ldc + col0;
#pragma unroll
                for (int bj = 0; bj < 2; ++bj) { const f32x4 v0 = acc[ai][bj][m][0] * sc, v1 = acc[ai][bj][m][1] * sc;
                    u32x4 w; w.x = cvt_pk_bf16(v0[0], v0[1]); w.y = cvt_pk_bf16(v0[2], v0[3]); w.z = cvt_pk_bf16(v1[0], v1[1]); w.w = cvt_pk_bf16(v1[2], v1[3]);
                    *(u32x4*)(rowp + bj * HALF) = w; } }
    }
};
struct EpiSwiGLU {
    static constexpr bool PERM = true, AFTER_DRAIN = false;
    bf16_t* H;
    __device__ __forceinline__ void operator()(const f32x4 (&acc)[2][2][4][2], const Unit& u, int wr, int wc, int fr, int fq) const {
        const int row0 = u.pm * BM + wr * 64 + fr, col0 = u.pn * HALF + wc * 32 + 8 * fq;
#pragma unroll
        for (int ai = 0; ai < 2; ++ai)
#pragma unroll
            for (int m = 0; m < 4; ++m) { float h[8];
#pragma unroll
                for (int n = 0; n < 2; ++n)
#pragma unroll
                    for (int e = 0; e < 4; ++e) { const float g = acc[ai][0][m][n][e], up = acc[ai][1][m][n][e];
                        h[4 * n + e] = g * __builtin_amdgcn_rcpf(1.0f + __builtin_amdgcn_exp2f(-LOG2E * g)) * up; }
                u32x4 w; w.x = cvt_pk_bf16(h[0], h[1]); w.y = cvt_pk_bf16(h[2], h[3]); w.z = cvt_pk_bf16(h[4], h[5]); w.w = cvt_pk_bf16(h[6], h[7]);
                *(u32x4*)(H + (size_t)(row0 + ai * HALF + m * 16) * DFF + col0) = w; }
    }
};
struct EpiF32p {
    static constexpr bool PERM = false, AFTER_DRAIN = false;
    float* O; int ldc;
    __device__ __forceinline__ void operator()(const f32x4 (&acc)[2][2][4][2], const Unit& u, int wr, int wc, int fr, int fq) const {
        const int col0 = u.pn * BM + wc * 32 + 4 * fq;
#pragma unroll
        for (int ai = 0; ai < 2; ++ai)
#pragma unroll
            for (int m = 0; m < 4; ++m) { const size_t off = (size_t)(u.pm * BM + ai * HALF + wr * 64 + m * 16 + fr) * ldc + col0;
#pragma unroll
                for (int bj = 0; bj < 2; ++bj)
#pragma unroll
                    for (int n = 0; n < 2; ++n) *(f32x4*)(O + off + bj * HALF + n * 16) = acc[ai][bj][m][n]; }
    }
};
template <class Epi, class Sched, bool ALIGN_EPI = false, bool SP2 = false>
__device__ __forceinline__ void gemm_phase(PG8_LAS unsigned char* lds, const Gemm g, const Sched& S, const Epi& E) {
    const int tid = threadIdx.x, wid = __builtin_amdgcn_readfirstlane(tid >> 6), lane = tid & 63, wr = wid >> 2, wc = wid & 3, fr = lane & 15, fq = lane >> 4;
    const int K = g.K, nt = K / BK;
    unsigned voffA[2], voffB[2];
#pragma unroll
    for (int i = 0; i < 2; ++i) { int R, C; stage_rc(tid * 16 + i * 8192, R, C); const int Rb = Epi::PERM ? ((R & ~31) + perm32(R & 31)) : R;
        voffA[i] = (unsigned)(R * K + C) * 2u; voffB[i] = (unsigned)(Rb * K + C) * 2u; }
    const size_t kstep = (size_t)(BK * 2);
    const size_t hstep = (size_t)HALF * K * 2;
    const size_t tstep = 2 * hstep;
    const unsigned ldsw = (unsigned)wid * 1024u;
    const int aoff = lds_byte(wr * 64 + fr, fq * 8), boff = lds_byte(wc * 32 + fr, fq * 8);
#define PG8_SA(b, h) (((b) * 2 + (h)) * HTB)
#define PG8_SB(b, h) ((4 + (b) * 2 + (h)) * HTB)
#define PG8_STAGE(bufoff, gbase, voff) do { _Pragma("unroll") for (int _i = 0; _i < 2; ++_i) \
        __builtin_amdgcn_global_load_lds((const unsigned*)((const char*)(gbase) + (voff)[_i]), (PG8_LAS unsigned*)(lds + (bufoff) + ldsw + _i * 8192), 16, 0, 0); } while (0)
#define PG8_LDA(dst, b, h) do { _Pragma("unroll") for (int m = 0; m < 4; ++m) _Pragma("unroll") for (int k = 0; k < 2; ++k) dst[m][k] = *(const PG8_LAS bf16x8*)(lds + PG8_SA(b, h) + aoff + m * 2048 + k * 1024); } while (0)
#define PG8_LDB(dst, b, h) do { _Pragma("unroll") for (int n = 0; n < 2; ++n) _Pragma("unroll") for (int k = 0; k < 2; ++k) dst[n][k] = *(const PG8_LAS bf16x8*)(lds + PG8_SB(b, h) + boff + n * 2048 + k * 1024); } while (0)
#define PG8_MMA(ai, bj, At, Bt) do { __builtin_amdgcn_s_setprio(1); _Pragma("unroll") for (int m = 0; m < 4; ++m) _Pragma("unroll") for (int n = 0; n < 2; ++n) _Pragma("unroll") for (int k = 0; k < 2; ++k) \
        acc[ai][bj][m][n] = __builtin_amdgcn_mfma_f32_16x16x32_bf16(Bt[n][k], At[m][k], acc[ai][bj][m][n], 0, 0, 0); __builtin_amdgcn_s_setprio(0); } while (0)
#define PG8_WAIT_V(n) asm volatile("s_waitcnt vmcnt(" #n ")" ::: "memory")
#define PG8_WAIT_L(n) asm volatile("s_waitcnt lgkmcnt(" #n ")" ::: "memory")
#define PG8_BAR __builtin_amdgcn_s_barrier()
#define PG8_SCHED __builtin_amdgcn_sched_barrier(0)
    Unit cur, nxt; int ui = 0;
    if (!S.next(0, cur)) return;
    f32x4 acc[2][2][4][2];
#pragma unroll
    for (int a = 0; a < 2; ++a)
#pragma unroll
        for (int b = 0; b < 2; ++b)
#pragma unroll
            for (int m = 0; m < 4; ++m)
#pragma unroll
                for (int n = 0; n < 2; ++n) acc[a][b][m][n] = (f32x4){0.f, 0.f, 0.f, 0.f};
    bf16x8 At[4][2], B0[2][2], B1[2][2];
    const char* cA = (const char*)g.A + (size_t)cur.pm * tstep; const char* cB = (const char*)g.Bt + (size_t)cur.pn * tstep;
    S.a_ready(cur);
    if constexpr (SP2) {
        PG8_STAGE(PG8_SB(0, 0), cB, voffB); PG8_STAGE(PG8_SB(0, 1), cB + hstep, voffB); PG8_STAGE(PG8_SA(0, 0), cA, voffA); PG8_STAGE(PG8_SA(0, 1), cA + hstep, voffA);
        if (wr == 1) PG8_BAR;
        PG8_WAIT_V(2); PG8_BAR;
        PG8_STAGE(PG8_SB(1, 0), cB + kstep, voffB); PG8_STAGE(PG8_SA(1, 0), cA + kstep, voffA); PG8_STAGE(PG8_SB(1, 1), cB + hstep + kstep, voffB);
        PG8_WAIT_V(6); PG8_BAR;
    } else {
        PG8_STAGE(PG8_SB(0, 0), cB, voffB); PG8_STAGE(PG8_SA(0, 0), cA, voffA); PG8_STAGE(PG8_SB(0, 1), cB + hstep, voffB); PG8_STAGE(PG8_SA(0, 1), cA + hstep, voffA);
        if (wr == 1) PG8_BAR;
        PG8_WAIT_V(4); PG8_BAR;
        PG8_STAGE(PG8_SB(1, 0), cB + kstep, voffB); PG8_STAGE(PG8_SA(1, 0), cA + kstep, voffA); PG8_STAGE(PG8_SB(1, 1), cB + hstep + kstep, voffB);
        PG8_WAIT_V(6); PG8_BAR;
    }
    for (;;) {
        const bool has_next = S.next(ui + 1, nxt);
        const char* nA = has_next ? (const char*)g.A + (size_t)nxt.pm * tstep : cA; const char* nB = has_next ? (const char*)g.Bt + (size_t)nxt.pn * tstep : cB;
        for (int t = 0; t < nt; t += 2) {
            const bool last = (t == nt - 2);
            const char* a1 = cA + (size_t)(t + 1) * kstep;
            const char* a2 = last ? nA : cA + (size_t)(t + 2) * kstep; const char* b2 = last ? nB : cB + (size_t)(t + 2) * kstep;
            const char* a3 = a2 + kstep; const char* b3 = b2 + kstep;
            if (last && has_next) S.a_ready(nxt);
            if constexpr (SP2) {
            PG8_LDB(B0, 0, 0); PG8_LDB(B1, 0, 1); PG8_SCHED; PG8_LDA(At, 0, 0); PG8_STAGE(PG8_SA(1, 1), a1 + hstep, voffA);
            PG8_WAIT_V(8); PG8_WAIT_L(0); PG8_BAR; PG8_MMA(0, 0, At, B0); PG8_MMA(0, 1, At, B1); PG8_BAR; PG8_SCHED;
            PG8_LDA(At, 0, 1); PG8_STAGE(PG8_SB(0, 0), b2, voffB); PG8_STAGE(PG8_SB(0, 1), b2 + hstep, voffB); PG8_STAGE(PG8_SA(0, 0), a2, voffA);
            PG8_WAIT_V(8); PG8_WAIT_L(0); PG8_BAR; PG8_MMA(1, 0, At, B0); PG8_MMA(1, 1, At, B1); PG8_BAR; PG8_SCHED;
            PG8_LDB(B0, 1, 0); PG8_LDB(B1, 1, 1); PG8_SCHED; PG8_LDA(At, 1, 0); PG8_STAGE(PG8_SA(0, 1), a2 + hstep, voffA);
            PG8_WAIT_V(8); PG8_WAIT_L(0); PG8_BAR; PG8_MMA(0, 0, At, B0); PG8_MMA(0, 1, At, B1); PG8_BAR; PG8_SCHED;
            PG8_LDA(At, 1, 1); PG8_STAGE(PG8_SB(1, 0), b3, voffB); PG8_STAGE(PG8_SB(1, 1), b3 + hstep, voffB); PG8_STAGE(PG8_SA(1, 0), a3, voffA);
            PG8_WAIT_V(8); PG8_WAIT_L(0); PG8_BAR; PG8_MMA(1, 0, At, B0); PG8_MMA(1, 1, At, B1); PG8_BAR; PG8_SCHED;
            } else {
            PG8_LDB(B0, 0, 0); PG8_SCHED; PG8_LDA(At, 0, 0); PG8_STAGE(PG8_SA(1, 1), a1 + hstep, voffA);
            PG8_WAIT_L(8); PG8_BAR; PG8_WAIT_L(0); PG8_MMA(0, 0, At, B0); PG8_BAR; PG8_SCHED;
            PG8_LDB(B1, 0, 1); PG8_STAGE(PG8_SB(0, 0), b2, voffB);
            PG8_BAR; PG8_WAIT_L(0); PG8_MMA(0, 1, At, B1); PG8_BAR;
            PG8_LDA(At, 0, 1); PG8_STAGE(PG8_SA(0, 0), a2, voffA);
            PG8_BAR; PG8_WAIT_L(0); PG8_MMA(1, 0, At, B0); PG8_BAR; PG8_SCHED;
            PG8_STAGE(PG8_SB(0, 1), b2 + hstep, voffB);
            PG8_WAIT_V(6); PG8_BAR; PG8_MMA(1, 1, At, B1); PG8_BAR;
            PG8_LDB(B0, 1, 0); PG8_SCHED; PG8_LDA(At, 1, 0); PG8_STAGE(PG8_SA(0, 1), a2 + hstep, voffA);
            PG8_WAIT_L(8); PG8_BAR; PG8_WAIT_L(0); PG8_MMA(0, 0, At, B0); PG8_BAR; PG8_SCHED;
            PG8_LDB(B1, 1, 1); PG8_STAGE(PG8_SB(1, 0), b3, voffB);
            PG8_BAR; PG8_WAIT_L(0); PG8_MMA(0, 1, At, B1); PG8_BAR;
            PG8_LDA(At, 1, 1); PG8_STAGE(PG8_SA(1, 0), a3, voffA);
            PG8_BAR; PG8_WAIT_L(0); PG8_MMA(1, 0, At, B0); PG8_BAR; PG8_SCHED;
            PG8_STAGE(PG8_SB(1, 1), b3 + hstep, voffB);
            PG8_WAIT_V(6); PG8_BAR; PG8_MMA(1, 1, At, B1); PG8_BAR;
            }
        }
        if constexpr (ALIGN_EPI) { if (wr == 0) PG8_BAR; }
        if constexpr (!Epi::AFTER_DRAIN) { E(acc, cur, wr, wc, fr, fq); S.done(cur); }
        if (!has_next) break;
#pragma unroll
        for (int a = 0; a < 2; ++a)
#pragma unroll
            for (int b = 0; b < 2; ++b)
#pragma unroll
                for (int m = 0; m < 4; ++m)
#pragma unroll
                    for (int n = 0; n < 2; ++n) acc[a][b][m][n] = (f32x4){0.f, 0.f, 0.f, 0.f};
        cur = nxt; cA = nA; cB = nB; ++ui;
        if constexpr (ALIGN_EPI) { if (wr == 1) PG8_BAR; }
    }
    PG8_WAIT_V(0);
    if constexpr (!ALIGN_EPI) { if (wr == 0) PG8_BAR; }
    PG8_BAR;
    if constexpr (Epi::AFTER_DRAIN) { E.fused(acc, cur, wr, wc, fr, fq, lds, wid, lane); S.done(cur); }
#undef PG8_SA
#undef PG8_SB
#undef PG8_STAGE
#undef PG8_LDA
#undef PG8_LDB
#undef PG8_MMA
#undef PG8_WAIT_V
#undef PG8_WAIT_L
#undef PG8_BAR
#undef PG8_SCHED
}
}

#define XB_TMO      128
#define XB_XCNT(j)  (256  + 64 * (j))
#define XB_XSUB(j)  (1280 + 64 * (j))
#define XB_XGEN(j)  (2304 + 64 * (j))
#define XB_TOP      3328
#define XB_TOPGEN   3392
#define XCD_BAR_WORDS 3456
#define XB_SPIN_CAP (1u << 18)

__device__ __forceinline__ unsigned xb_ld(unsigned* p)              { return __hip_atomic_load(p, __ATOMIC_RELAXED, __HIP_MEMORY_SCOPE_AGENT); }
__device__ __forceinline__ unsigned xb_add(unsigned* p, unsigned v) { return __hip_atomic_fetch_add(p, v, __ATOMIC_RELAXED, __HIP_MEMORY_SCOPE_AGENT); }
__device__ __forceinline__ unsigned xb_xcc_id() { return (unsigned)__builtin_amdgcn_s_getreg((3 << 11) | 20) & 0xFu; }
#define XB_SPIN(cond, bar) do { unsigned _sp = 0; while (cond) { __builtin_amdgcn_s_sleep(1); \
    if ((++_sp & 255u) == 0u) { if (xb_ld(&(bar)[XB_TMO])) break; if (_sp > XB_SPIN_CAP) { atomicAdd(&(bar)[XB_TMO], 1u); break; } } } } while (0)

struct XcdBarrier {
    unsigned* bar; unsigned x;
    volatile LAS unsigned* st;
};

__device__ __forceinline__ XcdBarrier xcd_barrier_post(unsigned* bar, volatile LAS unsigned* st) {
    XcdBarrier b; b.bar = bar; b.x = xb_xcc_id(); b.st = st;
    if (threadIdx.x == 0) (void)xb_add(&bar[XB_XCNT(b.x)], 1u);
    return b;
}
__device__ __forceinline__ void xcd_barrier_complete(unsigned* bar, unsigned x, unsigned& nloc, unsigned& nx) {
    const unsigned G = gridDim.x * gridDim.y * gridDim.z;
    unsigned sum, cnt, mine, sp = 0u;
    for (;;) {
        sum = 0u; cnt = 0u; mine = 0u;
#pragma unroll
        for (unsigned j = 0; j < 16; ++j) { const unsigned c = xb_ld(&bar[XB_XCNT(j)]); sum += c; cnt += (c > 0u) ? 1u : 0u; mine = (j == x) ? c : mine; }
        if (sum == G) break;
        __builtin_amdgcn_s_sleep(1);
        if ((++sp & 255u) == 0u) { if (xb_ld(&bar[XB_TMO])) break; if (sp > XB_SPIN_CAP) { atomicAdd(&bar[XB_TMO], 1u); break; } }
    }
    nloc = mine > 0u ? mine : 1u; nx = cnt > 0u ? cnt : 1u;
}

__device__ __forceinline__ void xcd_barrier(const XcdBarrier& b) {
    asm volatile("s_waitcnt vmcnt(0)" ::: "memory");
    __syncthreads();
    if (threadIdx.x == 0) {
        unsigned* bar = b.bar;
        __builtin_amdgcn_s_waitcnt(0);
        unsigned nloc = b.st[0], nx = b.st[1];
        if (nloc == 0u) { xcd_barrier_complete(bar, b.x, nloc, nx); b.st[0] = nloc; b.st[1] = nx; }
        const unsigned old = xb_add(&bar[XB_XSUB(b.x)], 1u);
        const unsigned gen = old / nloc;
        if (old + 1u == (gen + 1u) * nloc) {
            __builtin_amdgcn_fence(__ATOMIC_RELEASE, "agent");
            asm volatile("s_waitcnt vmcnt(0)" ::: "memory");
            const unsigned og = xb_add(&bar[XB_TOP], 1u);
            const unsigned tg = og / nx;
            if (og + 1u == (tg + 1u) * nx) xb_add(&bar[XB_TOPGEN], 1u);
            else XB_SPIN(xb_ld(&bar[XB_TOPGEN]) == tg, bar);
            __builtin_amdgcn_fence(__ATOMIC_ACQUIRE, "agent");
            xb_add(&bar[XB_XGEN(b.x)], 1u);
            asm volatile("s_waitcnt vmcnt(0)" ::: "memory");
        } else {
            XB_SPIN(xb_ld(&bar[XB_XGEN(b.x)]) == gen, bar);
            __builtin_amdgcn_fence(__ATOMIC_ACQUIRE, "agent");
            asm volatile("s_waitcnt vmcnt(0)" ::: "memory");
        }
    }
    __syncthreads();
}

struct RowAttn {
    float q[64], o[64], m, l;
    __device__ __forceinline__ void init(const bf16_t* qp) {
#pragma unroll
        for (int d = 0; d < 64; ++d) { q[d] = bf2f(qp[d]); o[d] = 0.f; } m = -INFINITY; l = 0.f; }
    __device__ __forceinline__ void key(const bf16_t* kp, const bf16_t* vp, float bias) {
        float s = 0.f;
#pragma unroll
        for (int d = 0; d < 64; d += 8) { const u32x4 kv = *(const u32x4*)(kp + d);
            s += q[d] * __uint_as_float(kv.x << 16) + q[d + 1] * __uint_as_float(kv.x & 0xffff0000u) + q[d + 2] * __uint_as_float(kv.y << 16) + q[d + 3] * __uint_as_float(kv.y & 0xffff0000u)
               + q[d + 4] * __uint_as_float(kv.z << 16) + q[d + 5] * __uint_as_float(kv.z & 0xffff0000u) + q[d + 6] * __uint_as_float(kv.w << 16) + q[d + 7] * __uint_as_float(kv.w & 0xffff0000u); }
        s += bias;
        const float mnew = fmaxf(m, s), alpha = exp2f(m - mnew), p = exp2f(s - mnew);
        l = l * alpha + p; m = mnew;
#pragma unroll
        for (int d = 0; d < 64; d += 8) { const u32x4 vv = *(const u32x4*)(vp + d);
            o[d] = o[d] * alpha + p * __uint_as_float(vv.x << 16); o[d + 1] = o[d + 1] * alpha + p * __uint_as_float(vv.x & 0xffff0000u);
            o[d + 2] = o[d + 2] * alpha + p * __uint_as_float(vv.y << 16); o[d + 3] = o[d + 3] * alpha + p * __uint_as_float(vv.y & 0xffff0000u);
            o[d + 4] = o[d + 4] * alpha + p * __uint_as_float(vv.z << 16); o[d + 5] = o[d + 5] * alpha + p * __uint_as_float(vv.z & 0xffff0000u);
            o[d + 6] = o[d + 6] * alpha + p * __uint_as_float(vv.w << 16); o[d + 7] = o[d + 7] * alpha + p * __uint_as_float(vv.w & 0xffff0000u); }
    }
    __device__ __forceinline__ void store(bf16_t* op) const { const float rl = 1.0f / l;
#pragma unroll
        for (int d = 0; d < 64; d += 2) *(unsigned*)(op + d) = pk2(o[d] * rl, o[d + 1] * rl); }
};
__device__ __forceinline__ void ph_fox_naive(const Ptrs& P, int vb) {
    const bf16_t* QKV = (const bf16_t*)(P.ws + WS_QKV); bf16_t* O = (bf16_t*)(P.ws + WS_O); const float* cc = (const float*)(P.ws + WS_C);
    const int s = vb * 8 + (threadIdx.x >> 6), h = s & 7, t = (s >> 3) * 64 + (threadIdx.x & 63);
    RowAttn ra; ra.init(QKV + (size_t)t * NQKV + h * 64);
    const float* ch = cc + (size_t)h * SEQ; const float ct = ch[t];
    const int tlast = (t | 63);
    for (int k = 0; k <= tlast; ++k) { const float bias = (k <= t) ? (ct - ch[k]) * LOG2E : -INFINITY;
        ra.key(QKV + (size_t)k * NQKV + 512 + h * 64, QKV + (size_t)k * NQKV + 1024 + h * 64, bias); }
    ra.store(O + (size_t)t * DM + h * 64);
}
__device__ __forceinline__ void ph_dil_naive(const Ptrs& P, int vb) {
    const bf16_t* QKV = (const bf16_t*)(P.ws + WS_QKV); bf16_t* O = (bf16_t*)(P.ws + WS_O); const float* btab = (const float*)(P.ws + WS_BTAB);
    const int s = vb * 8 + (threadIdx.x >> 6), h = s & 7, t = (s >> 3) * 64 + (threadIdx.x & 63);
    RowAttn ra; ra.init(QKV + (size_t)t * NQKV + 1536 + h * 64);
    for (int p = 0; p < 3; ++p) { const int dil = p == 0 ? 1 : (p == 1 ? 4 : 16); const float* bt = btab + (p * 8 + h) * BT_STRIDE;
        for (int j = 0; j <= 128; ++j) { const int k = t - j * dil; if (k < 0) break;
            ra.key(QKV + (size_t)k * NQKV + 2048 + h * 64, QKV + (size_t)k * NQKV + 2560 + h * 64, bt[j]); } }
    ra.store(O + (size_t)t * DM + 512 + h * 64);
}
__device__ __forceinline__ void ph_xattn_naive(const Ptrs& P, int vb, int nb) {
    const bf16_t* QX = (const bf16_t*)(P.ws + WS_QX); bf16_t* OX = (bf16_t*)(P.ws + WS_OX);
    const bf16_t* Kmem = (const bf16_t*)(P.ws + WS_KMEM); const bf16_t* Vmem = (const bf16_t*)(P.ws + WS_VMEM);
    for (int idx = vb * 512 + threadIdx.x; idx < 4 * SEQ; idx += nb * 512) { const int h = idx >> 14, t = idx & (SEQ - 1);
        RowAttn ra; ra.init(QX + (size_t)t * 256 + h * 64);
        for (int k = 0; k < NMEM; ++k) ra.key(Kmem + (size_t)k * 256 + h * 64, Vmem + (size_t)k * 256 + h * 64, 0.f);
        ra.store(OX + (size_t)t * 256 + h * 64); }
}
__device__ __forceinline__ void ph_norm_rows(const float* y, const float* base, const float* g1, float* out, const float* g2, bf16_t* hn, int vb, int nb) {
    const int lane = threadIdx.x & 63;
    for (int m = vb * 8 + (threadIdx.x >> 6); m < SEQ; m += nb * 8) {
        const f32x4* yr = (const f32x4*)(y + (size_t)m * DM) + lane; const f32x4* br = (const f32x4*)(base + (size_t)m * DM) + lane;
        f32x4 v[4]; float ss = 0.f;
#pragma unroll
        for (int j = 0; j < 4; ++j) { v[j] = yr[64 * j]; ss += (v[j].x * v[j].x + v[j].y * v[j].y) + (v[j].z * v[j].z + v[j].w * v[j].w); }
        const float rstd = 1.0f / sqrtf(wave_sum(ss) * (1.0f / DM) + RMS_EPS);
        float s2 = 0.f;
#pragma unroll
        for (int j = 0; j < 4; ++j) { const f32x4 g = ((const f32x4*)g1 + lane)[64 * j]; v[j] = br[64 * j] + v[j] * rstd * g; s2 += (v[j].x * v[j].x + v[j].y * v[j].y) + (v[j].z * v[j].z + v[j].w * v[j].w); }
        f32x4* orow = (f32x4*)(out + (size_t)m * DM) + lane;
#pragma unroll
        for (int j = 0; j < 4; ++j) orow[64 * j] = v[j];
        if (hn) {
            const float r2 = 1.0f / sqrtf(wave_sum(s2) * (1.0f / DM) + RMS_EPS);
            unsigned long long* o8 = (unsigned long long*)(hn + (size_t)m * DM) + lane;
#pragma unroll
            for (int j = 0; j < 4; ++j) { const f32x4 g = ((const f32x4*)g2 + lane)[64 * j]; const f32x4 w = v[j] * r2 * g; o8[64 * j] = (unsigned long long)pk2(w.x, w.y) | ((unsigned long long)pk2(w.z, w.w) << 32); }
        }
    }
}

constexpr int NWAVES = 8;
constexpr int RING_BYTES = 131072, LDSCTL_OFF = RING_BYTES, MISC_OFF = LDSCTL_OFF + 320, LDS_BYTES = 147456;
constexpr int CW_BAR = 4096;
constexpr int N_PHASES = 12;
struct MArgs { Ptrs p; int ph_lo, ph_hi, li, pad; };

__global__ void __launch_bounds__(NWAVES * 64, 2) mega(MArgs a) {
    extern __shared__ __attribute__((aligned(16))) unsigned char lds_raw[];
    LAS unsigned char* lds = (LAS unsigned char*)lds_raw;
    const Ptrs& P = a.p;
    const int tid = threadIdx.x, G = gridDim.x, vb = blockIdx.x;
    for (int u = tid; u < (LDS_BYTES - LDSCTL_OFF) / 4; u += NWAVES * 64) ((LAS unsigned*)(lds + LDSCTL_OFF))[u] = 0u;
    __syncthreads();
    unsigned char* ws = P.ws;
    unsigned* ctl = (unsigned*)(ws + WS_CTL);
    XcdBarrier bar = xcd_barrier_post(ctl + CW_BAR + a.li * XCD_BAR_WORDS, (volatile LAS unsigned*)(lds + MISC_OFF) + 8);
    const int lo = a.ph_lo, hi = a.ph_hi;
#define IN(k) (lo <= (k) && (k) < hi)
#define SEAM(k) do { if (IN(k) && IN((k) + 1)) xcd_barrier(bar); } while (0)
    bf16_t* Win = (bf16_t*)(ws + WS_WIN); bf16_t* Wout = (bf16_t*)(ws + WS_WOUT); bf16_t* Wxq = (bf16_t*)(ws + WS_WXQ); bf16_t* Wxo = (bf16_t*)(ws + WS_WXO);
    bf16_t* Wgu = (bf16_t*)(ws + WS_WGU); bf16_t* Wdn = (bf16_t*)(ws + WS_WDN);
    bf16_t* QKV = (bf16_t*)(ws + WS_QKV); bf16_t* QX = (bf16_t*)(ws + WS_QX); bf16_t* OX = (bf16_t*)(ws + WS_OX); bf16_t* HMID = (bf16_t*)(ws + WS_HMID);
    bf16_t* H1 = (bf16_t*)(ws + WS_H1); bf16_t* H3 = (bf16_t*)(ws + WS_H3); bf16_t* O = (bf16_t*)(ws + WS_O); bf16_t* H2 = (bf16_t*)(ws + WS_H2);
    float* Y = (float*)(ws + WS_Y);

    if (IN(0)) { p0_prologue(P, lds, vb, G); } SEAM(0);
    if (IN(1)) {
        if (vb < 8) cumsum_head(P, vb, lds);
        pg8::Gemm g{H1, Win, SEQ, NQKV, DM}; pg8::StaticOrder S; S.init(SEQ, NQKV, G, vb);
        pg8::EpiQKVp E{QKV};
        pg8::gemm_phase<pg8::EpiQKVp, pg8::StaticOrder, true, true>(lds, g, S, E);
    } SEAM(1);
    if (IN(2)) { ph_fox_naive(P, vb); ph_dil_naive(P, vb); } SEAM(2);
    if (IN(3)) {
        pg8::Gemm g{O, Wout, SEQ, DM, DM}; pg8::StaticOrder S; S.init(SEQ, DM, G, vb);
        pg8::EpiF32p E{Y, DM};
        pg8::gemm_phase<pg8::EpiF32p, pg8::StaticOrder, true, true>(lds, g, S, E);
    } SEAM(3);
    if (IN(4)) { ph_norm_rows(Y, P.in[0], P.in[7], P.out, P.in[8], H2, vb, G); } SEAM(4);
    if (IN(5)) {
        pg8::Gemm g{H2, Wxq, SEQ, 256, DM}; pg8::StaticOrder S; S.init(SEQ, 256, G, vb);
        pg8::EpiBfp E{QX, 256, C2};
        pg8::gemm_phase<pg8::EpiBfp, pg8::StaticOrder, true, true>(lds, g, S, E);
    } SEAM(5);
    if (IN(6)) { ph_xattn_naive(P, vb, G); } SEAM(6);
    if (IN(7)) {
        pg8::Gemm g{OX, Wxo, SEQ, DM, 256}; pg8::StaticOrder S; S.init(SEQ, DM, G, vb);
        pg8::EpiF32p E{Y, DM};
        pg8::gemm_phase<pg8::EpiF32p, pg8::StaticOrder, true, true>(lds, g, S, E);
    } SEAM(7);
    if (IN(8)) { ph_norm_rows(Y, P.out, P.in[14], P.out, P.in[15], H3, vb, G); } SEAM(8);
    if (IN(9)) {
        pg8::Gemm g{H3, Wgu, SEQ, NGU, DM}; pg8::StaticOrder S; S.init(SEQ, NGU, G, vb);
        pg8::EpiSwiGLU E{HMID};
        pg8::gemm_phase<pg8::EpiSwiGLU, pg8::StaticOrder, true, true>(lds, g, S, E);
    } SEAM(9);
    if (IN(10)) {
        pg8::Gemm g{HMID, Wdn, SEQ, DM, DFF}; pg8::StaticOrder S; S.init(SEQ, DM, G, vb);
        pg8::EpiF32p E{Y, DM};
        pg8::gemm_phase<pg8::EpiF32p, pg8::StaticOrder, true, true>(lds, g, S, E);
    } SEAM(10);
    if (IN(11)) { ph_norm_rows(Y, P.out, P.in[19], P.out, (const float*)nullptr, (bf16_t*)nullptr, vb, G); }
#undef IN
#undef SEAM
}

#ifndef MK_CUTS
#define MK_CUTS 0
#endif
extern "C" void kernel_launch(void* const* d_in, const int* in_sizes, int n_in, void* d_out, int out_size, void* d_ws, size_t ws_size, hipStream_t stream) {
    static int grid = 0;
    if (grid == 0) {
        if (n_in != 20 || out_size != SEQ * DM || ws_size < WS_END) { fprintf(stderr, "kernel_launch: unexpected problem (n_in %d out %d ws %zu)\n", n_in, out_size, ws_size); grid = -1; return; }
        int dev = 0, cus = 0, per_cu = 0;
        if (hipGetDevice(&dev) != hipSuccess || hipDeviceGetAttribute(&cus, hipDeviceAttributeMultiprocessorCount, dev) != hipSuccess) { grid = -1; return; }
        if (hipFuncSetAttribute((const void*)mega, hipFuncAttributeMaxDynamicSharedMemorySize, LDS_BYTES) != hipSuccess) { fprintf(stderr, "kernel_launch: hipFuncSetAttribute failed\n"); grid = -1; return; }
        if (hipOccupancyMaxActiveBlocksPerMultiprocessor(&per_cu, (const void*)mega, NWAVES * 64, LDS_BYTES) != hipSuccess || per_cu < 1) { fprintf(stderr, "kernel_launch: occupancy query says %d blocks per CU\n", per_cu); }
        (void)hipGetLastError();
        grid = cus;
    }
    if (grid < 0) return;
    hipMemsetAsync((char*)d_ws + WS_CTL, 0, 1 * MiB, stream);
    MArgs a{};
    for (int i = 0; i < 20; ++i) a.p.in[i] = (const float*)d_in[i];
    a.p.out = (float*)d_out; a.p.ws = (unsigned char*)d_ws;
#if MK_CUTS
    for (int ph = 0; ph < N_PHASES; ++ph) { a.ph_lo = ph; a.ph_hi = ph + 1; a.li = ph; a.pad = 0;
        void* args[] = {&a};
        hipLaunchCooperativeKernel((const void*)mega, dim3(grid), dim3(NWAVES * 64), args, LDS_BYTES, stream); }
#else
    a.ph_lo = 0; a.ph_hi = N_PHASES; a.li = 0; a.pad = 0;
    void* args[] = {&a};
    hipError_t e = hipLaunchCooperativeKernel((const void*)mega, dim3(grid), dim3(NWAVES * 64), args, LDS_BYTES, stream);
    if (e != hipSuccess) fprintf(stderr, "kernel_launch: cooperative launch failed: %s (grid %d)\n", hipGetErrorString(e), grid);
#endif
}
```

```cpp
#include <hip/hip_runtime.h>
#include <cstdint>
#include <cstdio>

#define LAS __attribute__((address_space(3)))
typedef unsigned short bf16_t;
typedef short bf16x8 __attribute__((ext_vector_type(8)));
typedef float f32x4 __attribute__((ext_vector_type(4)));
typedef float f32x16 __attribute__((ext_vector_type(16)));
typedef unsigned u32x4 __attribute__((ext_vector_type(4)));
typedef unsigned u32x2 __attribute__((ext_vector_type(2)));

constexpr int SEQ = 16384, DM = 1024, NMEM = 256, DFF = 2816;
constexpr int IN_COLS = 3080;
constexpr int NQKV = 3072;
constexpr int NGU = 2 * DFF;
constexpr float RMS_EPS = 1e-6f;
constexpr float LOG2E = 1.4426950408889634f;
constexpr float C2 = 0.125f * LOG2E;
constexpr int BT_STRIDE = 132;
constexpr int CW_KN2 = 1024;
constexpr int CW_QN2 = 1088;
constexpr int CW_QUEUE = 3200;

constexpr size_t MiB = 1u << 20;
constexpr size_t WS_CTL = 0;
constexpr size_t WS_WIN = 1 * MiB;
constexpr size_t WS_WOUT = 7 * MiB;
constexpr size_t WS_WXQ = 9 * MiB;
constexpr size_t WS_WXO = 9 * MiB + 512 * 1024;
constexpr size_t WS_WGU = 10 * MiB;
constexpr size_t WS_WDN = 21 * MiB;
constexpr size_t WS_QKV = 28 * MiB;
constexpr size_t WS_QX = 28 * MiB;
constexpr size_t WS_OX = 36 * MiB;
constexpr size_t WS_HMID = 28 * MiB;
constexpr size_t WS_H1 = 124 * MiB;
constexpr size_t WS_H3 = 124 * MiB;
constexpr size_t WS_O = 156 * MiB;
constexpr size_t WS_H2 = 156 * MiB;
constexpr size_t WS_Y = 188 * MiB;
constexpr size_t WS_LOGF = 252 * MiB;
constexpr size_t WS_C = 252 * MiB + 512 * 1024;
constexpr size_t WS_KMEM = 253 * MiB;
constexpr size_t WS_VMEM = 253 * MiB + 128 * 1024;
constexpr size_t WS_BTAB = 253 * MiB + 256 * 1024;
constexpr size_t WS_END = 256 * MiB;

__device__ __forceinline__ unsigned f2bf(float f) { unsigned u = __float_as_uint(f); return (u + 0x7fffu + ((u >> 16) & 1u)) >> 16; }
__device__ __forceinline__ unsigned pk2(float lo, float hi) { return f2bf(lo) | (f2bf(hi) << 16); }
__device__ __forceinline__ float bf2f(bf16_t b) { return __uint_as_float(((unsigned)b) << 16); }
__device__ __forceinline__ float wave_sum(float v) {
#pragma unroll
    for (int o = 1; o < 64; o <<= 1) v += __shfl_xor(v, o);
    return v;
}
__device__ __forceinline__ int t5_bucket(int dist) {
    if (dist < 16) return dist;
    int b = 16;
    b += dist >= 22; b += dist >= 30; b += dist >= 40; b += dist >= 54; b += dist >= 73; b += dist >= 99; b += dist >= 134; b += dist >= 182;
    b += dist >= 246; b += dist >= 332; b += dist >= 450; b += dist >= 609; b += dist >= 825; b += dist >= 1117; b += dist >= 1513;
    return b;
}

struct Ptrs {
    const float* in[20];
    float* out;
    unsigned char* ws;
};

__device__ __forceinline__ void p0_transpose_item(const float* W, int ldw, int scol0, bf16_t* WT, int ldt, int drow0, int k0, LAS float* scr, int lane) {
#pragma unroll 8
    for (int i = 0; i < 32; ++i) { const int kk = 2 * i + (lane >> 5); scr[kk * 33 + (lane & 31)] = W[(size_t)(k0 + kk) * ldw + scol0 + (lane & 31)]; }
    asm volatile("s_waitcnt lgkmcnt(0)" ::: "memory");
    const int c = lane & 7;
#pragma unroll
    for (int j = 0; j < 4; ++j) { const int n = (lane >> 3) + 8 * j; const LAS float* s = scr + (8 * c) * 33 + n;
        u32x4 o; o.x = pk2(s[0 * 33], s[1 * 33]); o.y = pk2(s[2 * 33], s[3 * 33]); o.z = pk2(s[4 * 33], s[5 * 33]); o.w = pk2(s[6 * 33], s[7 * 33]);
        *(u32x4*)(WT + (size_t)(drow0 + n) * ldt + k0 + 8 * c) = o; }
    asm volatile("s_waitcnt lgkmcnt(0)" ::: "memory");
}

__device__ __forceinline__ void p0_weights(const Ptrs& P, LAS float* scr, int gw, int ngw, int lane) {
    unsigned char* ws = P.ws;
    bf16_t* Win = (bf16_t*)(ws + WS_WIN); bf16_t* Wout = (bf16_t*)(ws + WS_WOUT); bf16_t* Wxq = (bf16_t*)(ws + WS_WXQ); bf16_t* Wxo = (bf16_t*)(ws + WS_WXO);
    bf16_t* Wgu = (bf16_t*)(ws + WS_WGU); bf16_t* Wdn = (bf16_t*)(ws + WS_WDN);
    constexpr int I_IN = (DM / 64) * (1536 / 32);
    constexpr int I_OUT = (DM / 64) * (DM / 32);
    constexpr int I_XQ = (DM / 64) * (256 / 32);
    constexpr int I_XO = (256 / 64) * (DM / 32);
    constexpr int I_G = (DM / 64) * (DFF / 32);
    constexpr int I_DN = (DFF / 64) * (DM / 32);
    constexpr int NITEMS = 2 * I_IN + I_OUT + I_XQ + I_XO + 2 * I_G + I_DN;
    for (int it = gw; it < NITEMS; it += ngw) {
        int r = it;
        if (r < I_IN) { const int nb = r % 48, kb = r / 48; p0_transpose_item(P.in[3], IN_COLS, 32 * nb, Win, DM, 32 * nb, 64 * kb, scr, lane); continue; } r -= I_IN;
        if (r < I_IN) { const int nb = r % 48, kb = r / 48; p0_transpose_item(P.in[3], IN_COLS, 1544 + 32 * nb, Win, DM, 1536 + 32 * nb, 64 * kb, scr, lane); continue; } r -= I_IN;
        if (r < I_OUT) { const int nb = r % 32, kb = r / 32; p0_transpose_item(P.in[6], DM, 32 * nb, Wout, DM, 32 * nb, 64 * kb, scr, lane); continue; } r -= I_OUT;
        if (r < I_XQ) { const int nb = r % 8, kb = r / 8; p0_transpose_item(P.in[10], 256, 32 * nb, Wxq, DM, 32 * nb, 64 * kb, scr, lane); continue; } r -= I_XQ;
        if (r < I_XO) { const int nb = r % 32, kb = r / 32; p0_transpose_item(P.in[13], DM, 32 * nb, Wxo, 256, 32 * nb, 64 * kb, scr, lane); continue; } r -= I_XO;
        if (r < I_G) { const int nb = r % 88, kb = r / 88; const int n0 = 32 * nb; p0_transpose_item(P.in[16], DFF, n0, Wgu, DM, (n0 >> 7) * 256 + (n0 & 127), 64 * kb, scr, lane); continue; } r -= I_G;
        if (r < I_G) { const int nb = r % 88, kb = r / 88; const int n0 = 32 * nb; p0_transpose_item(P.in[17], DFF, n0, Wgu, DM, (n0 >> 7) * 256 + 128 + (n0 & 127), 64 * kb, scr, lane); continue; } r -= I_G;
        { const int nb = r % 32, kb = r / 32; p0_transpose_item(P.in[18], DM, 32 * nb, Wdn, DFF, 32 * nb, 64 * kb, scr, lane); }
    }
}

__device__ __forceinline__ void p0_row(const Ptrs& P, int m, const LAS float* wg, int lane) {
    const f32x4* xr = (const f32x4*)(P.in[0] + (size_t)m * DM) + lane;
    const f32x4* gr = (const f32x4*)P.in[2] + lane;
    f32x4 v[4]; float ss = 0.f;
#pragma unroll
    for (int j = 0; j < 4; ++j) { v[j] = xr[64 * j]; ss += (v[j].x * v[j].x + v[j].y * v[j].y) + (v[j].z * v[j].z + v[j].w * v[j].w); }
    const float rstd = 1.0f / sqrtf(wave_sum(ss) * (1.0f / DM) + RMS_EPS);
#pragma unroll
    for (int j = 0; j < 4; ++j) { const f32x4 g = gr[64 * j]; v[j] = v[j] * rstd * g; }
    unsigned long long* o8 = (unsigned long long*)((bf16_t*)(P.ws + WS_H1) + (size_t)m * DM) + lane;
#pragma unroll
    for (int j = 0; j < 4; ++j) o8[64 * j] = (unsigned long long)pk2(v[j].x, v[j].y) | ((unsigned long long)pk2(v[j].z, v[j].w) << 32);
    float gs[8];
#pragma unroll
    for (int c = 0; c < 8; ++c) { float a = 0.f;
#pragma unroll
        for (int j = 0; j < 4; ++j) { const f32x4 w = *(const LAS f32x4*)(wg + c * 1024 + 256 * j + 4 * lane); a += (v[j].x * w.x + v[j].y * w.y) + (v[j].z * w.z + v[j].w * w.w); }
        gs[c] = wave_sum(a); }
    if (lane < 8) {
        float z = 0.f;
#pragma unroll
        for (int c = 0; c < 8; ++c) z = (lane == c) ? gs[c] : z;
        z += P.in[4][lane];
        const float lf = (z >= 0.f) ? -log1pf(expf(-z)) : (z - log1pf(expf(z)));
        ((float*)(P.ws + WS_LOGF))[(size_t)lane * SEQ + m] = lf;
    }
}

__device__ __forceinline__ void p0_memkv_unit(const Ptrs& P, int unit, LAS float* lds, int tid) {
    const int rb = unit >> 4, cb = unit & 15, wave = tid >> 6, lane = tid & 63;
    const float* W = cb < 8 ? P.in[11] : P.in[12]; const int c0 = (cb & 7) * 32;
    bf16_t* Out = (bf16_t*)(P.ws + (cb < 8 ? WS_KMEM : WS_VMEM));
#pragma unroll
    for (int rr = 0; rr < 2; ++rr) { const int r = 2 * wave + rr;
        const f32x4* xr = (const f32x4*)(P.in[1] + (size_t)(16 * rb + r) * DM) + lane; const f32x4* gr = (const f32x4*)P.in[9] + lane;
        f32x4 v[4]; float ss = 0.f;
#pragma unroll
        for (int j = 0; j < 4; ++j) { v[j] = xr[64 * j]; ss += (v[j].x * v[j].x + v[j].y * v[j].y) + (v[j].z * v[j].z + v[j].w * v[j].w); }
        const float rstd = 1.0f / sqrtf(wave_sum(ss) * (1.0f / DM) + RMS_EPS);
#pragma unroll
        for (int j = 0; j < 4; ++j) { const f32x4 g = gr[64 * j]; *(LAS f32x4*)(lds + r * 1024 + 256 * j + 4 * lane) = v[j] * rstd * g; } }
    __syncthreads();
    const int col = lane & 31, kh = lane >> 5, kbase = wave * 128 + kh * 64;
    float acc[16];
#pragma unroll
    for (int r = 0; r < 16; ++r) acc[r] = 0.f;
#pragma unroll 2
    for (int i = 0; i < 64; i += 4) {
        const float w0 = W[(size_t)(kbase + i) * 256 + c0 + col], w1 = W[(size_t)(kbase + i + 1) * 256 + c0 + col];
        const float w2 = W[(size_t)(kbase + i + 2) * 256 + c0 + col], w3 = W[(size_t)(kbase + i + 3) * 256 + c0 + col];
#pragma unroll
        for (int r = 0; r < 16; ++r) { const f32x4 hv = *(const LAS f32x4*)(lds + r * 1024 + kbase + i); acc[r] += (hv.x * w0 + hv.y * w1) + (hv.z * w2 + hv.w * w3); }
    }
    __syncthreads();
#pragma unroll
    for (int r = 0; r < 16; ++r) lds[((wave * 2 + kh) * 16 + r) * 32 + col] = acc[r];
    __syncthreads();
    { float s = 0.f;
#pragma unroll
      for (int p = 0; p < 16; ++p) s += lds[(p * 16 + (tid >> 5)) * 32 + (tid & 31)];
      Out[(size_t)(16 * rb + (tid >> 5)) * 256 + c0 + (tid & 31)] = (bf16_t)f2bf(s); }
    __syncthreads();
}

__device__ __forceinline__ void p0_prologue(const Ptrs& P, LAS unsigned char* ldsb, int vb, int nb) {
    const int tid = threadIdx.x, lane = tid & 63, wave = tid >> 6;
    LAS float* lds = (LAS float*)ldsb;
    for (int u = vb; u < 256; u += nb) p0_memkv_unit(P, u, lds, tid);
    for (int i = vb * 512 + tid; i < 3 * 8 * 129; i += nb * 512) { const int j = i % 129, ph = i / 129, h = ph & 7, p = ph >> 3; const int dil = p == 0 ? 1 : (p == 1 ? 4 : 16);
        ((float*)(P.ws + WS_BTAB))[ph * BT_STRIDE + j] = P.in[5][t5_bucket(j * dil) * 8 + h] * LOG2E; }
    for (int i = tid; i < 8 * 1024; i += 512) { const int k = i >> 3, c = i & 7; lds[c * 1024 + k] = P.in[3][(size_t)k * IN_COLS + 1536 + c]; }
    __syncthreads();
    const int gw = vb * 8 + wave, ngw = nb * 8;
    for (int m = gw; m < SEQ; m += ngw) p0_row(P, m, lds, lane);
    p0_weights(P, lds + 8192 + wave * (64 * 33), gw, ngw, lane);
}

constexpr int P0_LDS = 65536 + 8 * 64 * 33 * 4;


__device__ __forceinline__ void cumsum_head(const Ptrs& P, int h, LAS unsigned char* ldsb) {
    const int tid = threadIdx.x;
    LAS double* sd = (LAS double*)ldsb;
    const float* lf = (const float*)(P.ws + WS_LOGF) + (size_t)h * SEQ + tid * 32;
    float* cc = (float*)(P.ws + WS_C) + (size_t)h * SEQ + tid * 32;
    f32x4 v[8]; double s = 0.0;
#pragma unroll
    for (int i = 0; i < 8; ++i) { v[i] = ((const f32x4*)lf)[i]; s += (double)v[i].x + (double)v[i].y + (double)v[i].z + (double)v[i].w; }
    sd[tid] = s;
    __syncthreads();
    for (int off = 1; off < 512; off <<= 1) { double t = (tid >= off) ? sd[tid - off] : 0.0; __syncthreads(); sd[tid] += t; __syncthreads(); }
    double run = (tid > 0) ? sd[tid - 1] : 0.0;
#pragma unroll
    for (int i = 0; i < 8; ++i) { f32x4 o; run += (double)v[i].x; o.x = (float)run; run += (double)v[i].y; o.y = (float)run; run += (double)v[i].z; o.z = (float)run; run += (double)v[i].w; o.w = (float)run; ((f32x4*)cc)[i] = o; }
    __syncthreads();
}


namespace pg8 {
#define PG8_LAS __attribute__((address_space(3)))
typedef unsigned short bf16_t;
typedef short bf16x8 __attribute__((ext_vector_type(8)));
typedef float f32x4 __attribute__((ext_vector_type(4)));
typedef unsigned u32x4 __attribute__((ext_vector_type(4)));
constexpr int BM = 256, BK = 64, HALF = 128, HTB = HALF * BK * 2  , STAGE_BYTES = 8 * HTB, NXCD = 8, WGM = 8;

__host__ __device__ __forceinline__ int lds_byte(int r, int c) { const int st = (r >> 4) * 2 + (c >> 5), rr = r & 15, cc = c & 31, ob = rr * 64 + cc * 2; return st * 1024 + (ob ^ (((ob >> 9) & 1) << 5)); }
__host__ __device__ __forceinline__ void stage_rc(int b, int& R, int& C) { const int st = b / 1024, sb = b % 1024, swz = sb ^ (((sb >> 9) & 1) << 5); R = (st >> 1) * 16 + swz / 64; C = (st & 1) * 32 + (swz % 64) / 2; }
__host__ __device__ __forceinline__ int perm32(int rho) { const int n = rho >> 4, i = rho & 15; return 8 * (i >> 2) + 4 * n + (i & 3); }

struct Unit { int pm, pn; };
struct Gemm { const bf16_t* A; const bf16_t* Bt; int M, N, K; };

struct StaticOrder {
    int nM, nN, nwg, G, c;
    __host__ __device__ void init(int M, int N, int G_, int c_) { nM = M / BM; nN = N / BM; nwg = nM * nN; G = G_; c = c_; }
    __host__ __device__ bool next(int i, Unit& u) const {
        const long L = (long)i * G + c; if (L >= nwg) return false;
        int wgid = (int)L; { const int q = nwg / NXCD, r = nwg % NXCD, xcd = wgid % NXCD, off = wgid / NXCD; wgid = (xcd < r ? xcd * (q + 1) : r * (q + 1) + (xcd - r) * q) + off; }
        const int nig = WGM * nN, gid = wgid / nig, fm = gid * WGM, gsz = (nM - fm) < WGM ? (nM - fm) : WGM;
        u.pm = fm + ((wgid % nig) % gsz); u.pn = (wgid % nig) / gsz; return true;
    }
    __device__ __forceinline__ void a_ready(const Unit&) const {}
    __device__ __forceinline__ void done(const Unit&) const {}
};

__device__ __forceinline__ unsigned cvt_pk_bf16(float lo, float hi) { unsigned r; asm volatile("v_cvt_pk_bf16_f32 %0, %1, %2" : "=v"(r) : "v"(lo), "v"(hi)); return r; }
typedef float f32x2 __attribute__((ext_vector_type(2)));
struct EpiQKVp {
    static constexpr bool PERM = true, AFTER_DRAIN = false;
    bf16_t* O; unsigned* ctl;
    __device__ __forceinline__ void operator()(const f32x4 (&acc)[2][2][4][2], const Unit& u, int wr, int wc, int fr, int fq) const {
        const int row0 = u.pm * BM + wr * 64 + fr, col0 = u.pn * BM + wc * 32 + 8 * fq;
        const float sc = (u.pn < 2 || u.pn == 6 || u.pn == 7) ? C2 : 1.f;
        if (u.pn < 4) {
            float mx[2] = {0.f, 0.f};
#pragma unroll
            for (int ai = 0; ai < 2; ++ai)
#pragma unroll
                for (int m = 0; m < 4; ++m)
#pragma unroll
                    for (int bj = 0; bj < 2; ++bj) { const f32x4 a = acc[ai][bj][m][0] * sc, b = acc[ai][bj][m][1] * sc;
                        float q2 = (a[0] * a[0] + a[1] * a[1]) + (a[2] * a[2] + a[3] * a[3]) + (b[0] * b[0] + b[1] * b[1]) + (b[2] * b[2] + b[3] * b[3]);
                        q2 += __shfl_xor(q2, 16); q2 += __shfl_xor(q2, 32); mx[bj] = fmaxf(mx[bj], q2); }
#pragma unroll
            for (int bj = 0; bj < 2; ++bj) { float t = mx[bj];
                t = fmaxf(t, __shfl_xor(t, 1)); t = fmaxf(t, __shfl_xor(t, 2)); t = fmaxf(t, __shfl_xor(t, 4)); t = fmaxf(t, __shfl_xor(t, 8));
                if (fr == 0 && fq == 0) { const int head = (u.pn & 1) * 4 + bj * 2 + (wc >> 1), half = wc & 1;
                    unsigned* w = (u.pn < 2) ? ctl + CW_QN2 + (head * 64 + u.pm) * 2 + half : ctl + CW_KN2 + head * 2 + half;
                    atomicMax(w, __float_as_uint(t)); } }
        }
#pragma unroll
        for (int ai = 0; ai < 2; ++ai)
#pragma unroll
            for (int m = 0; m < 4; ++m) { bf16_t* rowp = O + (size_t)(row0 + ai * HALF + m * 16) * NQKV + col0;
#pragma unroll
                for (int bj = 0; bj < 2; ++bj) { const f32x4 v0 = acc[ai][bj][m][0] * sc, v1 = acc[ai][bj][m][1] * sc;
                    u32x4 w; w.x = cvt_pk_bf16(v0[0], v0[1]); w.y = cvt_pk_bf16(v0[2], v0[3]); w.z = cvt_pk_bf16(v1[0], v1[1]); w.w = cvt_pk_bf16(v1[2], v1[3]);
                    *(u32x4*)(rowp + bj * HALF) = w; } }
    }
};
struct EpiBfp {
    static constexpr bool PERM = true, AFTER_DRAIN = false;
    bf16_t* O; int ldc; float sc;
    __device__ __forceinline__ void operator()(const f32x4 (&acc)[2][2][4][2], const Unit& u, int wr, int wc, int fr, int fq) const {
        const int row0 = u.pm * BM + wr * 64 + fr, col0 = u.pn * BM + wc * 32 + 8 * fq;
#pragma unroll
        for (int ai = 0; ai < 2; ++ai)
#pragma unroll
            for (int m = 0; m < 4; ++m) { bf16_t* rowp = O + (size_t)(row0 + ai * HALF + m * 16) * ldc + col0;
#pragma unroll
                for (int bj = 0; bj < 2; ++bj) { const f32x4 v0 = acc[ai][bj][m][0] * sc, v1 = acc[ai][bj][m][1] * sc;
                    u32x4 w; w.x = cvt_pk_bf16(v0[0], v0[1]); w.y = cvt_pk_bf16(v0[2], v0[3]); w.z = cvt_pk_bf16(v1[0], v1[1]); w.w = cvt_pk_bf16(v1[2], v1[3]);
                    *(u32x4*)(rowp + bj * HALF) = w; } }
    }
};
struct EpiSwiGLU {
    static constexpr bool PERM = true, AFTER_DRAIN = false;
    bf16_t* H;
    __device__ __forceinline__ void operator()(const f32x4 (&acc)[2][2][4][2], const Unit& u, int wr, int wc, int fr, int fq) const {
        const int row0 = u.pm * BM + wr * 64 + fr, col0 = u.pn * HALF + wc * 32 + 8 * fq;
#pragma unroll
        for (int ai = 0; ai < 2; ++ai)
#pragma unroll
            for (int m = 0; m < 4; ++m) { float h[8];
#pragma unroll
                for (int n = 0; n < 2; ++n)
#pragma unroll
                    for (int e = 0; e < 4; ++e) { const float g = acc[ai][0][m][n][e], up = acc[ai][1][m][n][e];
                        h[4 * n + e] = g * __builtin_amdgcn_rcpf(1.0f + __builtin_amdgcn_exp2f(-LOG2E * g)) * up; }
                u32x4 w; w.x = cvt_pk_bf16(h[0], h[1]); w.y = cvt_pk_bf16(h[2], h[3]); w.z = cvt_pk_bf16(h[4], h[5]); w.w = cvt_pk_bf16(h[6], h[7]);
                *(u32x4*)(H + (size_t)(row0 + ai * HALF + m * 16) * DFF + col0) = w; }
    }
};
struct EpiF32p {
    static constexpr bool PERM = false, AFTER_DRAIN = false;
    float* O; int ldc;
    __device__ __forceinline__ void operator()(const f32x4 (&acc)[2][2][4][2], const Unit& u, int wr, int wc, int fr, int fq) const {
        const int col0 = u.pn * BM + wc * 32 + 4 * fq;
#pragma unroll
        for (int ai = 0; ai < 2; ++ai)
#pragma unroll
            for (int m = 0; m < 4; ++m) { const size_t off = (size_t)(u.pm * BM + ai * HALF + wr * 64 + m * 16 + fr) * ldc + col0;
#pragma unroll
                for (int bj = 0; bj < 2; ++bj)
#pragma unroll
                    for (int n = 0; n < 2; ++n) *(f32x4*)(O + off + bj * HALF + n * 16) = acc[ai][bj][m][n]; }
    }
};
template <class Epi, class Sched, bool ALIGN_EPI = false, bool SP2 = false>
__device__ __forceinline__ void gemm_phase(PG8_LAS unsigned char* lds, const Gemm g, const Sched& S, const Epi& E) {
    const int tid = threadIdx.x, wid = __builtin_amdgcn_readfirstlane(tid >> 6), lane = tid & 63, wr = wid >> 2, wc = wid & 3, fr = lane & 15, fq = lane >> 4;
    const int K = g.K, nt = K / BK;
    unsigned voffA[2], voffB[2];
#pragma unroll
    for (int i = 0; i < 2; ++i) { int R, C; stage_rc(tid * 16 + i * 8192, R, C); const int Rb = Epi::PERM ? ((R & ~31) + perm32(R & 31)) : R;
        voffA[i] = (unsigned)(R * K + C) * 2u; voffB[i] = (unsigned)(Rb * K + C) * 2u; }
    const size_t kstep = (size_t)(BK * 2);
    const size_t hstep = (size_t)HALF * K * 2;
    const size_t tstep = 2 * hstep;
    const unsigned ldsw = (unsigned)wid * 1024u;
    const int aoff = lds_byte(wr * 64 + fr, fq * 8), boff = lds_byte(wc * 32 + fr, fq * 8);
#define PG8_SA(b, h) (((b) * 2 + (h)) * HTB)
#define PG8_SB(b, h) ((4 + (b) * 2 + (h)) * HTB)
#define PG8_STAGE(bufoff, gbase, voff) do { _Pragma("unroll") for (int _i = 0; _i < 2; ++_i) \
        __builtin_amdgcn_global_load_lds((const unsigned*)((const char*)(gbase) + (voff)[_i]), (PG8_LAS unsigned*)(lds + (bufoff) + ldsw + _i * 8192), 16, 0, 0); } while (0)
#define PG8_LDA(dst, b, h) do { _Pragma("unroll") for (int m = 0; m < 4; ++m) _Pragma("unroll") for (int k = 0; k < 2; ++k) dst[m][k] = *(const PG8_LAS bf16x8*)(lds + PG8_SA(b, h) + aoff + m * 2048 + k * 1024); } while (0)
#define PG8_LDB(dst, b, h) do { _Pragma("unroll") for (int n = 0; n < 2; ++n) _Pragma("unroll") for (int k = 0; k < 2; ++k) dst[n][k] = *(const PG8_LAS bf16x8*)(lds + PG8_SB(b, h) + boff + n * 2048 + k * 1024); } while (0)
#define PG8_MMA(ai, bj, At, Bt) do { __builtin_amdgcn_s_setprio(1); _Pragma("unroll") for (int m = 0; m < 4; ++m) _Pragma("unroll") for (int n = 0; n < 2; ++n) _Pragma("unroll") for (int k = 0; k < 2; ++k) \
        acc[ai][bj][m][n] = __builtin_amdgcn_mfma_f32_16x16x32_bf16(Bt[n][k], At[m][k], acc[ai][bj][m][n], 0, 0, 0); __builtin_amdgcn_s_setprio(0); } while (0)
#define PG8_WAIT_V(n) asm volatile("s_waitcnt vmcnt(" #n ")" ::: "memory")
#define PG8_WAIT_L(n) asm volatile("s_waitcnt lgkmcnt(" #n ")" ::: "memory")
#define PG8_BAR __builtin_amdgcn_s_barrier()
#define PG8_SCHED __builtin_amdgcn_sched_barrier(0)
    Unit cur, nxt; int ui = 0;
    if (!S.next(0, cur)) return;
    f32x4 acc[2][2][4][2];
#pragma unroll
    for (int a = 0; a < 2; ++a)
#pragma unroll
        for (int b = 0; b < 2; ++b)
#pragma unroll
            for (int m = 0; m < 4; ++m)
#pragma unroll
                for (int n = 0; n < 2; ++n) acc[a][b][m][n] = (f32x4){0.f, 0.f, 0.f, 0.f};
    bf16x8 At[4][2], B0[2][2], B1[2][2];
    const char* cA = (const char*)g.A + (size_t)cur.pm * tstep; const char* cB = (const char*)g.Bt + (size_t)cur.pn * tstep;
    S.a_ready(cur);
    if constexpr (SP2) {
        PG8_STAGE(PG8_SB(0, 0), cB, voffB); PG8_STAGE(PG8_SB(0, 1), cB + hstep, voffB); PG8_STAGE(PG8_SA(0, 0), cA, voffA); PG8_STAGE(PG8_SA(0, 1), cA + hstep, voffA);
        if (wr == 1) PG8_BAR;
        PG8_WAIT_V(2); PG8_BAR;
        PG8_STAGE(PG8_SB(1, 0), cB + kstep, voffB); PG8_STAGE(PG8_SA(1, 0), cA + kstep, voffA); PG8_STAGE(PG8_SB(1, 1), cB + hstep + kstep, voffB);
        PG8_WAIT_V(6); PG8_BAR;
    } else {
        PG8_STAGE(PG8_SB(0, 0), cB, voffB); PG8_STAGE(PG8_SA(0, 0), cA, voffA); PG8_STAGE(PG8_SB(0, 1), cB + hstep, voffB); PG8_STAGE(PG8_SA(0, 1), cA + hstep, voffA);
        if (wr == 1) PG8_BAR;
        PG8_WAIT_V(4); PG8_BAR;
        PG8_STAGE(PG8_SB(1, 0), cB + kstep, voffB); PG8_STAGE(PG8_SA(1, 0), cA + kstep, voffA); PG8_STAGE(PG8_SB(1, 1), cB + hstep + kstep, voffB);
        PG8_WAIT_V(6); PG8_BAR;
    }
    for (;;) {
        const bool has_next = S.next(ui + 1, nxt);
        const char* nA = has_next ? (const char*)g.A + (size_t)nxt.pm * tstep : cA; const char* nB = has_next ? (const char*)g.Bt + (size_t)nxt.pn * tstep : cB;
        for (int t = 0; t < nt; t += 2) {
            const bool last = (t == nt - 2);
            const char* a1 = cA + (size_t)(t + 1) * kstep;
            const char* a2 = last ? nA : cA + (size_t)(t + 2) * kstep; const char* b2 = last ? nB : cB + (size_t)(t + 2) * kstep;
            const char* a3 = a2 + kstep; const char* b3 = b2 + kstep;
            if (last && has_next) S.a_ready(nxt);
            if constexpr (SP2) {
            PG8_LDB(B0, 0, 0); PG8_LDB(B1, 0, 1); PG8_SCHED; PG8_LDA(At, 0, 0); PG8_STAGE(PG8_SA(1, 1), a1 + hstep, voffA);
            PG8_WAIT_V(8); PG8_WAIT_L(0); PG8_BAR; PG8_MMA(0, 0, At, B0); PG8_MMA(0, 1, At, B1); PG8_BAR; PG8_SCHED;
            PG8_LDA(At, 0, 1); PG8_STAGE(PG8_SB(0, 0), b2, voffB); PG8_STAGE(PG8_SB(0, 1), b2 + hstep, voffB); PG8_STAGE(PG8_SA(0, 0), a2, voffA);
            PG8_WAIT_V(8); PG8_WAIT_L(0); PG8_BAR; PG8_MMA(1, 0, At, B0); PG8_MMA(1, 1, At, B1); PG8_BAR; PG8_SCHED;
            PG8_LDB(B0, 1, 0); PG8_LDB(B1, 1, 1); PG8_SCHED; PG8_LDA(At, 1, 0); PG8_STAGE(PG8_SA(0, 1), a2 + hstep, voffA);
            PG8_WAIT_V(8); PG8_WAIT_L(0); PG8_BAR; PG8_MMA(0, 0, At, B0); PG8_MMA(0, 1, At, B1); PG8_BAR; PG8_SCHED;
            PG8_LDA(At, 1, 1); PG8_STAGE(PG8_SB(1, 0), b3, voffB); PG8_STAGE(PG8_SB(1, 1), b3 + hstep, voffB); PG8_STAGE(PG8_SA(1, 0), a3, voffA);
            PG8_WAIT_V(8); PG8_WAIT_L(0); PG8_BAR; PG8_MMA(1, 0, At, B0); PG8_MMA(1, 1, At, B1); PG8_BAR; PG8_SCHED;
            } else {
            PG8_LDB(B0, 0, 0); PG8_SCHED; PG8_LDA(At, 0, 0); PG8_STAGE(PG8_SA(1, 1), a1 + hstep, voffA);
            PG8_WAIT_L(8); PG8_BAR; PG8_WAIT_L(0); PG8_MMA(0, 0, At, B0); PG8_BAR; PG8_SCHED;
            PG8_LDB(B1, 0, 1); PG8_STAGE(PG8_SB(0, 0), b2, voffB);
            PG8_BAR; PG8_WAIT_L(0); PG8_MMA(0, 1, At, B1); PG8_BAR;
            PG8_LDA(At, 0, 1); PG8_STAGE(PG8_SA(0, 0), a2, voffA);
            PG8_BAR; PG8_WAIT_L(0); PG8_MMA(1, 0, At, B0); PG8_BAR; PG8_SCHED;
            PG8_STAGE(PG8_SB(0, 1), b2 + hstep, voffB);
            PG8_WAIT_V(6); PG8_BAR; PG8_MMA(1, 1, At, B1); PG8_BAR;
            PG8_LDB(B0, 1, 0); PG8_SCHED; PG8_LDA(At, 1, 0); PG8_STAGE(PG8_SA(0, 1), a2 + hstep, voffA);
            PG8_WAIT_L(8); PG8_BAR; PG8_WAIT_L(0); PG8_MMA(0, 0, At, B0); PG8_BAR; PG8_SCHED;
            PG8_LDB(B1, 1, 1); PG8_STAGE(PG8_SB(1, 0), b3, voffB);
            PG8_BAR; PG8_WAIT_L(0); PG8_MMA(0, 1, At, B1); PG8_BAR;
            PG8_LDA(At, 1, 1); PG8_STAGE(PG8_SA(1, 0), a3, voffA);
            PG8_BAR; PG8_WAIT_L(0); PG8_MMA(1, 0, At, B0); PG8_BAR; PG8_SCHED;
            PG8_STAGE(PG8_SB(1, 1), b3 + hstep, voffB);
            PG8_WAIT_V(6); PG8_BAR; PG8_MMA(1, 1, At, B1); PG8_BAR;
            }
        }
        if constexpr (ALIGN_EPI) { if (wr == 0) PG8_BAR; }
        if constexpr (!Epi::AFTER_DRAIN) { E(acc, cur, wr, wc, fr, fq); S.done(cur); }
        if (!has_next) break;
#pragma unroll
        for (int a = 0; a < 2; ++a)
#pragma unroll
            for (int b = 0; b < 2; ++b)
#pragma unroll
                for (int m = 0; m < 4; ++m)
#pragma unroll
                    for (int n = 0; n < 2; ++n) acc[a][b][m][n] = (f32x4){0.f, 0.f, 0.f, 0.f};
        cur = nxt; cA = nA; cB = nB; ++ui;
        if constexpr (ALIGN_EPI) { if (wr == 1) PG8_BAR; }
    }
    PG8_WAIT_V(0);
    if constexpr (!ALIGN_EPI) { if (wr == 0) PG8_BAR; }
    PG8_BAR;
    if constexpr (Epi::AFTER_DRAIN) { E.fused(acc, cur, wr, wc, fr, fq, lds, wid, lane); S.done(cur); }
#undef PG8_SA
#undef PG8_SB
#undef PG8_STAGE
#undef PG8_LDA
#undef PG8_LDB
#undef PG8_MMA
#undef PG8_WAIT_V
#undef PG8_WAIT_L
#undef PG8_BAR
#undef PG8_SCHED
}
}

#define XB_TMO      128
#define XB_XCNT(j)  (256  + 64 * (j))
#define XB_XSUB(j)  (1280 + 64 * (j))
#define XB_XGEN(j)  (2304 + 64 * (j))
#define XB_TOP      3328
#define XB_TOPGEN   3392
#define XCD_BAR_WORDS 3456
#define XB_SPIN_CAP (1u << 18)

__device__ __forceinline__ unsigned xb_ld(unsigned* p)              { return __hip_atomic_load(p, __ATOMIC_RELAXED, __HIP_MEMORY_SCOPE_AGENT); }
__device__ __forceinline__ unsigned xb_add(unsigned* p, unsigned v) { return __hip_atomic_fetch_add(p, v, __ATOMIC_RELAXED, __HIP_MEMORY_SCOPE_AGENT); }
__device__ __forceinline__ unsigned xb_xcc_id() { return (unsigned)__builtin_amdgcn_s_getreg((3 << 11) | 20) & 0xFu; }
#define XB_SPIN(cond, bar) do { unsigned _sp = 0; while (cond) { __builtin_amdgcn_s_sleep(1); \
    if ((++_sp & 255u) == 0u) { if (xb_ld(&(bar)[XB_TMO])) break; if (_sp > XB_SPIN_CAP) { atomicAdd(&(bar)[XB_TMO], 1u); break; } } } } while (0)

struct XcdBarrier {
    unsigned* bar; unsigned x;
    volatile LAS unsigned* st;
};

__device__ __forceinline__ XcdBarrier xcd_barrier_post(unsigned* bar, volatile LAS unsigned* st) {
    XcdBarrier b; b.bar = bar; b.x = xb_xcc_id(); b.st = st;
    if (threadIdx.x == 0) (void)xb_add(&bar[XB_XCNT(b.x)], 1u);
    return b;
}
__device__ __forceinline__ void xcd_barrier_complete(unsigned* bar, unsigned x, unsigned& nloc, unsigned& nx) {
    const unsigned G = gridDim.x * gridDim.y * gridDim.z;
    unsigned sum, cnt, mine, sp = 0u;
    for (;;) {
        sum = 0u; cnt = 0u; mine = 0u;
#pragma unroll
        for (unsigned j = 0; j < 16; ++j) { const unsigned c = xb_ld(&bar[XB_XCNT(j)]); sum += c; cnt += (c > 0u) ? 1u : 0u; mine = (j == x) ? c : mine; }
        if (sum == G) break;
        __builtin_amdgcn_s_sleep(1);
        if ((++sp & 255u) == 0u) { if (xb_ld(&bar[XB_TMO])) break; if (sp > XB_SPIN_CAP) { atomicAdd(&bar[XB_TMO], 1u); break; } }
    }
    nloc = mine > 0u ? mine : 1u; nx = cnt > 0u ? cnt : 1u;
}

__device__ __forceinline__ void xcd_barrier(const XcdBarrier& b) {
    asm volatile("s_waitcnt vmcnt(0)" ::: "memory");
    __syncthreads();
    if (threadIdx.x == 0) {
        unsigned* bar = b.bar;
        __builtin_amdgcn_s_waitcnt(0);
        unsigned nloc = b.st[0], nx = b.st[1];
        if (nloc == 0u) { xcd_barrier_complete(bar, b.x, nloc, nx); b.st[0] = nloc; b.st[1] = nx; }
        const unsigned old = xb_add(&bar[XB_XSUB(b.x)], 1u);
        const unsigned gen = old / nloc;
        if (old + 1u == (gen + 1u) * nloc) {
            __builtin_amdgcn_fence(__ATOMIC_RELEASE, "agent");
            asm volatile("s_waitcnt vmcnt(0)" ::: "memory");
            const unsigned og = xb_add(&bar[XB_TOP], 1u);
            const unsigned tg = og / nx;
            if (og + 1u == (tg + 1u) * nx) xb_add(&bar[XB_TOPGEN], 1u);
            else XB_SPIN(xb_ld(&bar[XB_TOPGEN]) == tg, bar);
            __builtin_amdgcn_fence(__ATOMIC_ACQUIRE, "agent");
            xb_add(&bar[XB_XGEN(b.x)], 1u);
            asm volatile("s_waitcnt vmcnt(0)" ::: "memory");
        } else {
            XB_SPIN(xb_ld(&bar[XB_XGEN(b.x)]) == gen, bar);
            __builtin_amdgcn_fence(__ATOMIC_ACQUIRE, "agent");
            asm volatile("s_waitcnt vmcnt(0)" ::: "memory");
        }
    }
    __syncthreads();
}

struct RowAttn {
    float q[64], o[64], m, l;
    __device__ __forceinline__ void init(const bf16_t* qp) {
#pragma unroll
        for (int d = 0; d < 64; ++d) { q[d] = bf2f(qp[d]); o[d] = 0.f; } m = -INFINITY; l = 0.f; }
    __device__ __forceinline__ void key(const bf16_t* kp, const bf16_t* vp, float bias) {
        float s = 0.f;
#pragma unroll
        for (int d = 0; d < 64; d += 8) { const u32x4 kv = *(const u32x4*)(kp + d);
            s += q[d] * __uint_as_float(kv.x << 16) + q[d + 1] * __uint_as_float(kv.x & 0xffff0000u) + q[d + 2] * __uint_as_float(kv.y << 16) + q[d + 3] * __uint_as_float(kv.y & 0xffff0000u)
               + q[d + 4] * __uint_as_float(kv.z << 16) + q[d + 5] * __uint_as_float(kv.z & 0xffff0000u) + q[d + 6] * __uint_as_float(kv.w << 16) + q[d + 7] * __uint_as_float(kv.w & 0xffff0000u); }
        s += bias;
        const float mnew = fmaxf(m, s), alpha = exp2f(m - mnew), p = exp2f(s - mnew);
        l = l * alpha + p; m = mnew;
#pragma unroll
        for (int d = 0; d < 64; d += 8) { const u32x4 vv = *(const u32x4*)(vp + d);
            o[d] = o[d] * alpha + p * __uint_as_float(vv.x << 16); o[d + 1] = o[d + 1] * alpha + p * __uint_as_float(vv.x & 0xffff0000u);
            o[d + 2] = o[d + 2] * alpha + p * __uint_as_float(vv.y << 16); o[d + 3] = o[d + 3] * alpha + p * __uint_as_float(vv.y & 0xffff0000u);
            o[d + 4] = o[d + 4] * alpha + p * __uint_as_float(vv.z << 16); o[d + 5] = o[d + 5] * alpha + p * __uint_as_float(vv.z & 0xffff0000u);
            o[d + 6] = o[d + 6] * alpha + p * __uint_as_float(vv.w << 16); o[d + 7] = o[d + 7] * alpha + p * __uint_as_float(vv.w & 0xffff0000u); }
    }
    __device__ __forceinline__ void store(bf16_t* op) const { const float rl = 1.0f / l;
#pragma unroll
        for (int d = 0; d < 64; d += 2) *(unsigned*)(op + d) = pk2(o[d] * rl, o[d + 1] * rl); }
};
namespace fox {
typedef short s16x4 __attribute__((ext_vector_type(4)));
typedef short v4i16_t __attribute__((ext_vector_type(4)));
constexpr float NEG = -1.0e30f;
constexpr int LDS_K = 0, LDS_V = 16384, LDS_C = 32768, LDS_MISC = 33792;
__device__ __forceinline__ int crow(int r, int hi) { return (r & 3) + 8 * (r >> 2) + 4 * hi; }
__device__ __forceinline__ s16x4 vtr(const LAS unsigned char* p) { return __builtin_bit_cast(s16x4, __builtin_amdgcn_ds_read_tr16_b64_v4i16((LAS v4i16_t*)p)); }
__device__ __forceinline__ unsigned cvtpk(float lo, float hi) { typedef float f2 __attribute__((ext_vector_type(2))); typedef __bf16 b2 __attribute__((ext_vector_type(2)));
    f2 v = {lo, hi}; b2 b = __builtin_convertvector(v, b2); return __builtin_bit_cast(unsigned, b); }
__device__ __forceinline__ bf16x8 pack8(const f32x16& p, int s) {
    u32x4 w; w.x = cvtpk(p[8 * s], p[8 * s + 1]); w.y = cvtpk(p[8 * s + 2], p[8 * s + 3]); w.z = cvtpk(p[8 * s + 4], p[8 * s + 5]); w.w = cvtpk(p[8 * s + 6], p[8 * s + 7]);
    return __builtin_bit_cast(bf16x8, w); }

__device__ __forceinline__ void unit(const Ptrs& P, int h, int qb, int jlo, LAS unsigned char* lds) {
    const int tid = threadIdx.x, lane = tid & 63, wave = __builtin_amdgcn_readfirstlane(tid >> 6), r32 = lane & 31, hi = lane >> 5;
    const bf16_t* QKV = (const bf16_t*)(P.ws + WS_QKV);
    const bf16_t* Qh = QKV + h * 64; const bf16_t* Kh = QKV + 512 + h * 64; const bf16_t* Vh = QKV + 1024 + h * 64;
    const float* ch = (const float*)(P.ws + WS_C) + (size_t)h * SEQ;
    const int q0w = qb * 256 + wave * 32, q = q0w + r32, jhi = 4 * qb + 3;
    bf16x8 qr[4];
#pragma unroll
    for (int ds = 0; ds < 4; ++ds) qr[ds] = *(const bf16x8*)(Qh + (size_t)q * NQKV + ds * 16 + hi * 8);
    const float cq = ch[q] * LOG2E;
    const bf16_t* ksrc = Kh + (size_t)lane * NQKV + wave * 8;
    const bf16_t* vsrc = Vh + (size_t)(16 * (wave & 3) + (lane >> 2)) * NQKV + (wave >> 2) * 32 + (lane & 3) * 8;
    const int sdst = wave * 1024 + lane * 16;
    LAS float* Cb = (LAS float*)(lds + LDS_C);
    u32x4 kreg, vreg; float creg = 0.f;
#define FOX_LOAD(j) do { kreg = *(const u32x4*)(ksrc + (size_t)(j) * 64 * NQKV); vreg = *(const u32x4*)(vsrc + (size_t)(j) * 64 * NQKV); if (wave == 0) creg = ch[(j) * 64 + lane] * LOG2E; } while (0)
#define FOX_STORE(b) do { *(LAS u32x4*)(lds + LDS_K + (b) * 8192 + sdst) = kreg; *(LAS u32x4*)(lds + LDS_V + (b) * 8192 + sdst) = vreg; if (wave == 0) Cb[(b) * 64 + lane] = creg; } while (0)
    float m = NEG, l = 0.f;
    f32x16 o[2];
#pragma unroll
    for (int i = 0; i < 16; ++i) { o[0][i] = 0.f; o[1][i] = 0.f; }
    FOX_LOAD(jlo); FOX_STORE(0);
    for (int j = jlo; j <= jhi; ++j) {
        const int b = (j - jlo) & 1;
        __syncthreads();
        if (j < jhi) FOX_LOAD(j + 1);
        if (j * 64 <= q0w + 31) {
            const LAS unsigned char* kp = lds + LDS_K + b * 8192 + hi * 1024 + r32 * 16;
            f32x16 p0, p1;
#pragma unroll
            for (int i = 0; i < 16; ++i) { p0[i] = 0.f; p1[i] = 0.f; }
#pragma unroll
            for (int ds = 0; ds < 4; ++ds) { const bf16x8 k0 = *(const LAS bf16x8*)(kp + ds * 2048), k1 = *(const LAS bf16x8*)(kp + ds * 2048 + 512);
                p0 = __builtin_amdgcn_mfma_f32_32x32x16_bf16(k0, qr[ds], p0, 0, 0, 0); p1 = __builtin_amdgcn_mfma_f32_32x32x16_bf16(k1, qr[ds], p1, 0, 0, 0); }
            const LAS float* cb = Cb + b * 64 + 4 * hi;
#pragma unroll
            for (int g = 0; g < 4; ++g) { const f32x4 c0 = *(const LAS f32x4*)(cb + 8 * g), c1 = *(const LAS f32x4*)(cb + 32 + 8 * g);
#pragma unroll
                for (int e = 0; e < 4; ++e) { p0[4 * g + e] += cq - c0[e]; p1[4 * g + e] += cq - c1[e]; } }
            if (j * 64 + 63 > q0w) {
#pragma unroll
                for (int r = 0; r < 16; ++r) { const int kv = j * 64 + crow(r, hi); if (kv > q) p0[r] = NEG; if (kv + 32 > q) p1[r] = NEG; }
            }
            float rm = fmaxf(p0[0], p1[0]);
#pragma unroll
            for (int r = 1; r < 16; ++r) rm = fmaxf(rm, fmaxf(p0[r], p1[r]));
            rm = fmaxf(rm, __shfl_xor(rm, 32));
            const float mnew = fmaxf(m, rm), alpha = __builtin_amdgcn_exp2f(m - mnew);
            m = mnew;
            float rs = 0.f;
#pragma unroll
            for (int r = 0; r < 16; ++r) { p0[r] = __builtin_amdgcn_exp2f(p0[r] - mnew); p1[r] = __builtin_amdgcn_exp2f(p1[r] - mnew); rs += p0[r] + p1[r]; }
            l = l * alpha + rs;
#pragma unroll
            for (int i = 0; i < 16; ++i) { o[0][i] *= alpha; o[1][i] *= alpha; }
            bf16x8 pb[4]; pb[0] = pack8(p0, 0); pb[1] = pack8(p0, 1); pb[2] = pack8(p1, 0); pb[3] = pack8(p1, 1);
            const LAS unsigned char* vp = lds + LDS_V + b * 8192 + ((lane >> 4) & 1) * 32 + (lane & 3) * 8 + (4 * hi + ((lane & 15) >> 2)) * 64;
#pragma unroll
            for (int d0 = 0; d0 < 2; ++d0)
#pragma unroll
                for (int ks = 0; ks < 4; ++ks) { const s16x4 lo = vtr(vp + d0 * 4096 + ks * 1024), hh = vtr(vp + d0 * 4096 + ks * 1024 + 512);
                    const bf16x8 vf = (bf16x8){lo[0], lo[1], lo[2], lo[3], hh[0], hh[1], hh[2], hh[3]};
                    o[d0] = __builtin_amdgcn_mfma_f32_32x32x16_bf16(vf, pb[ks], o[d0], 0, 0, 0); }
        }
        if (j < jhi) FOX_STORE(b ^ 1);
    }
#undef FOX_LOAD
#undef FOX_STORE
    l += __shfl_xor(l, 32);
    const float rl = 1.0f / l;
    bf16_t* op = (bf16_t*)(P.ws + WS_O) + (size_t)q * DM + h * 64 + 4 * hi;
#pragma unroll
    for (int d0 = 0; d0 < 2; ++d0)
#pragma unroll
        for (int g = 0; g < 4; ++g) { u32x2 w; w.x = cvtpk(o[d0][4 * g] * rl, o[d0][4 * g + 1] * rl); w.y = cvtpk(o[d0][4 * g + 2] * rl, o[d0][4 * g + 3] * rl);
            *(u32x2*)(op + 32 * d0 + 8 * g) = w; }
    __syncthreads();
}
__device__ __forceinline__ int first_tile(const Ptrs& P, int h, int qb, LAS unsigned char* lds) {
    const unsigned* ctl = (const unsigned*)(P.ws + WS_CTL);
    const float* ch = (const float*)(P.ws + WS_C) + (size_t)h * SEQ;
    LAS unsigned* cnt = (LAS unsigned*)(lds + LDS_MISC);
    const int tid = threadIdx.x;
    const float qn2 = __uint_as_float(ctl[CW_QN2 + (h * 64 + qb) * 2]) + __uint_as_float(ctl[CW_QN2 + (h * 64 + qb) * 2 + 1]);
    const float kn2 = __uint_as_float(ctl[CW_KN2 + h * 2]) + __uint_as_float(ctl[CW_KN2 + h * 2 + 1]);
    const float B = sqrtf(qn2 * kn2) * 1.01f;
    const float cthr = ch[qb * 256] * LOG2E + 150.0f + 2.0f * B;
    if (tid == 0) cnt[0] = 0u;
    __syncthreads();
    const bool skip = (tid < 4 * qb) && (ch[tid * 64 + 63] * LOG2E > cthr);
    const unsigned long long bal = __ballot(skip);
    if ((tid & 63) == 0 && bal) atomicAdd((unsigned*)cnt, (unsigned)__popcll(bal));
    __syncthreads();
    const int jlo = (int)cnt[0];
    __syncthreads();
    return jlo;
}
__device__ __forceinline__ void phase(const Ptrs& P, LAS unsigned char* lds) {
    unsigned* head = (unsigned*)(P.ws + WS_CTL) + CW_QUEUE;
    LAS unsigned* slot = (LAS unsigned*)(lds + LDS_MISC) + 4;
    for (;;) {
        if (threadIdx.x == 0) slot[0] = atomicAdd(head, 1u);
        __syncthreads();
        const int u = (int)slot[0];
        __syncthreads();
        if (u >= 512) break;
        const int h = u & 7, qb = 63 - (u >> 3);
        const int jlo = first_tile(P, h, qb, lds);
        unit(P, h, qb, jlo, lds);
    }
}
}

__device__ __forceinline__ void ph_fox_naive(const Ptrs& P, int vb) {
    const bf16_t* QKV = (const bf16_t*)(P.ws + WS_QKV); bf16_t* O = (bf16_t*)(P.ws + WS_O); const float* cc = (const float*)(P.ws + WS_C);
    const int s = vb * 8 + (threadIdx.x >> 6), h = s & 7, t = (s >> 3) * 64 + (threadIdx.x & 63);
    RowAttn ra; ra.init(QKV + (size_t)t * NQKV + h * 64);
    const float* ch = cc + (size_t)h * SEQ; const float ct = ch[t];
    const int tlast = (t | 63);
    for (int k = 0; k <= tlast; ++k) { const float bias = (k <= t) ? (ct - ch[k]) * LOG2E : -INFINITY;
        ra.key(QKV + (size_t)k * NQKV + 512 + h * 64, QKV + (size_t)k * NQKV + 1024 + h * 64, bias); }
    ra.store(O + (size_t)t * DM + h * 64);
}
__device__ __forceinline__ void ph_dil_naive(const Ptrs& P, int vb) {
    const bf16_t* QKV = (const bf16_t*)(P.ws + WS_QKV); bf16_t* O = (bf16_t*)(P.ws + WS_O); const float* btab = (const float*)(P.ws + WS_BTAB);
    const int s = vb * 8 + (threadIdx.x >> 6), h = s & 7, t = (s >> 3) * 64 + (threadIdx.x & 63);
    RowAttn ra; ra.init(QKV + (size_t)t * NQKV + 1536 + h * 64);
    for (int p = 0; p < 3; ++p) { const int dil = p == 0 ? 1 : (p == 1 ? 4 : 16); const float* bt = btab + (p * 8 + h) * BT_STRIDE;
        for (int j = 0; j <= 128; ++j) { const int k = t - j * dil; if (k < 0) break;
            ra.key(QKV + (size_t)k * NQKV + 2048 + h * 64, QKV + (size_t)k * NQKV + 2560 + h * 64, bt[j]); } }
    ra.store(O + (size_t)t * DM + 512 + h * 64);
}
__device__ __forceinline__ void ph_xattn_naive(const Ptrs& P, int vb, int nb) {
    const bf16_t* QX = (const bf16_t*)(P.ws + WS_QX); bf16_t* OX = (bf16_t*)(P.ws + WS_OX);
    const bf16_t* Kmem = (const bf16_t*)(P.ws + WS_KMEM); const bf16_t* Vmem = (const bf16_t*)(P.ws + WS_VMEM);
    for (int idx = vb * 512 + threadIdx.x; idx < 4 * SEQ; idx += nb * 512) { const int h = idx >> 14, t = idx & (SEQ - 1);
        RowAttn ra; ra.init(QX + (size_t)t * 256 + h * 64);
        for (int k = 0; k < NMEM; ++k) ra.key(Kmem + (size_t)k * 256 + h * 64, Vmem + (size_t)k * 256 + h * 64, 0.f);
        ra.store(OX + (size_t)t * 256 + h * 64); }
}
__device__ __forceinline__ void ph_norm_rows(const float* y, const float* base, const float* g1, float* out, const float* g2, bf16_t* hn, int vb, int nb) {
    const int lane = threadIdx.x & 63;
    for (int m = vb * 8 + (threadIdx.x >> 6); m < SEQ; m += nb * 8) {
        const f32x4* yr = (const f32x4*)(y + (size_t)m * DM) + lane; const f32x4* br = (const f32x4*)(base + (size_t)m * DM) + lane;
        f32x4 v[4]; float ss = 0.f;
#pragma unroll
        for (int j = 0; j < 4; ++j) { v[j] = yr[64 * j]; ss += (v[j].x * v[j].x + v[j].y * v[j].y) + (v[j].z * v[j].z + v[j].w * v[j].w); }
        const float rstd = 1.0f / sqrtf(wave_sum(ss) * (1.0f / DM) + RMS_EPS);
        float s2 = 0.f;
#pragma unroll
        for (int j = 0; j < 4; ++j) { const f32x4 g = ((const f32x4*)g1 + lane)[64 * j]; v[j] = br[64 * j] + v[j] * rstd * g; s2 += (v[j].x * v[j].x + v[j].y * v[j].y) + (v[j].z * v[j].z + v[j].w * v[j].w); }
        f32x4* orow = (f32x4*)(out + (size_t)m * DM) + lane;
#pragma unroll
        for (int j = 0; j < 4; ++j) orow[64 * j] = v[j];
        if (hn) {
            const float r2 = 1.0f / sqrtf(wave_sum(s2) * (1.0f / DM) + RMS_EPS);
            unsigned long long* o8 = (unsigned long long*)(hn + (size_t)m * DM) + lane;
#pragma unroll
            for (int j = 0; j < 4; ++j) { const f32x4 g = ((const f32x4*)g2 + lane)[64 * j]; const f32x4 w = v[j] * r2 * g; o8[64 * j] = (unsigned long long)pk2(w.x, w.y) | ((unsigned long long)pk2(w.z, w.w) << 32); }
        }
    }
}

constexpr int NWAVES = 8;
constexpr int RING_BYTES = 131072, LDSCTL_OFF = RING_BYTES, MISC_OFF = LDSCTL_OFF + 320, LDS_BYTES = 147456;
constexpr int CW_BAR = 4096;
constexpr int N_PHASES = 12;
struct MArgs { Ptrs p; int ph_lo, ph_hi, li, pad; };

__global__ void __launch_bounds__(NWAVES * 64, 2) mega(MArgs a) {
    extern __shared__ __attribute__((aligned(16))) unsigned char lds_raw[];
    LAS unsigned char* lds = (LAS unsigned char*)lds_raw;
    const Ptrs& P = a.p;
    const int tid = threadIdx.x, G = gridDim.x, vb = blockIdx.x;
    for (int u = tid; u < (LDS_BYTES - LDSCTL_OFF) / 4; u += NWAVES * 64) ((LAS unsigned*)(lds + LDSCTL_OFF))[u] = 0u;
    __syncthreads();
    unsigned char* ws = P.ws;
    unsigned* ctl = (unsigned*)(ws + WS_CTL);
    XcdBarrier bar = xcd_barrier_post(ctl + CW_BAR + a.li * XCD_BAR_WORDS, (volatile LAS unsigned*)(lds + MISC_OFF) + 8);
    const int lo = a.ph_lo, hi = a.ph_hi;
#define IN(k) (lo <= (k) && (k) < hi)
#define SEAM(k) do { if (IN(k) && IN((k) + 1)) xcd_barrier(bar); } while (0)
    bf16_t* Win = (bf16_t*)(ws + WS_WIN); bf16_t* Wout = (bf16_t*)(ws + WS_WOUT); bf16_t* Wxq = (bf16_t*)(ws + WS_WXQ); bf16_t* Wxo = (bf16_t*)(ws + WS_WXO);
    bf16_t* Wgu = (bf16_t*)(ws + WS_WGU); bf16_t* Wdn = (bf16_t*)(ws + WS_WDN);
    bf16_t* QKV = (bf16_t*)(ws + WS_QKV); bf16_t* QX = (bf16_t*)(ws + WS_QX); bf16_t* OX = (bf16_t*)(ws + WS_OX); bf16_t* HMID = (bf16_t*)(ws + WS_HMID);
    bf16_t* H1 = (bf16_t*)(ws + WS_H1); bf16_t* H3 = (bf16_t*)(ws + WS_H3); bf16_t* O = (bf16_t*)(ws + WS_O); bf16_t* H2 = (bf16_t*)(ws + WS_H2);
    float* Y = (float*)(ws + WS_Y);

    if (IN(0)) { p0_prologue(P, lds, vb, G); } SEAM(0);
    if (IN(1)) {
        if (vb < 8) cumsum_head(P, vb, lds);
        pg8::Gemm g{H1, Win, SEQ, NQKV, DM}; pg8::StaticOrder S; S.init(SEQ, NQKV, G, vb);
        pg8::EpiQKVp E{QKV, ctl};
        pg8::gemm_phase<pg8::EpiQKVp, pg8::StaticOrder, true, true>(lds, g, S, E);
    } SEAM(1);
    if (IN(2)) { fox::phase(P, lds); ph_dil_naive(P, vb); } SEAM(2);
    if (IN(3)) {
        pg8::Gemm g{O, Wout, SEQ, DM, DM}; pg8::StaticOrder S; S.init(SEQ, DM, G, vb);
        pg8::EpiF32p E{Y, DM};
        pg8::gemm_phase<pg8::EpiF32p, pg8::StaticOrder, true, true>(lds, g, S, E);
    } SEAM(3);
    if (IN(4)) { ph_norm_rows(Y, P.in[0], P.in[7], P.out, P.in[8], H2, vb, G); } SEAM(4);
    if (IN(5)) {
        pg8::Gemm g{H2, Wxq, SEQ, 256, DM}; pg8::StaticOrder S; S.init(SEQ, 256, G, vb);
        pg8::EpiBfp E{QX, 256, C2};
        pg8::gemm_phase<pg8::EpiBfp, pg8::StaticOrder, true, true>(lds, g, S, E);
    } SEAM(5);
    if (IN(6)) { ph_xattn_naive(P, vb, G); } SEAM(6);
    if (IN(7)) {
        pg8::Gemm g{OX, Wxo, SEQ, DM, 256}; pg8::StaticOrder S; S.init(SEQ, DM, G, vb);
        pg8::EpiF32p E{Y, DM};
        pg8::gemm_phase<pg8::EpiF32p, pg8::StaticOrder, true, true>(lds, g, S, E);
    } SEAM(7);
    if (IN(8)) { ph_norm_rows(Y, P.out, P.in[14], P.out, P.in[15], H3, vb, G); } SEAM(8);
    if (IN(9)) {
        pg8::Gemm g{H3, Wgu, SEQ, NGU, DM}; pg8::StaticOrder S; S.init(SEQ, NGU, G, vb);
        pg8::EpiSwiGLU E{HMID};
        pg8::gemm_phase<pg8::EpiSwiGLU, pg8::StaticOrder, true, true>(lds, g, S, E);
    } SEAM(9);
    if (IN(10)) {
        pg8::Gemm g{HMID, Wdn, SEQ, DM, DFF}; pg8::StaticOrder S; S.init(SEQ, DM, G, vb);
        pg8::EpiF32p E{Y, DM};
        pg8::gemm_phase<pg8::EpiF32p, pg8::StaticOrder, true, true>(lds, g, S, E);
    } SEAM(10);
    if (IN(11)) { ph_norm_rows(Y, P.out, P.in[19], P.out, (const float*)nullptr, (bf16_t*)nullptr, vb, G); }
#undef IN
#undef SEAM
}

#ifndef MK_CUTS
#define MK_CUTS 0
#endif
extern "C" void kernel_launch(void* const* d_in, const int* in_sizes, int n_in, void* d_out, int out_size, void* d_ws, size_t ws_size, hipStream_t stream) {
    static int grid = 0;
    if (grid == 0) {
        if (n_in != 20 || out_size != SEQ * DM || ws_size < WS_END) { fprintf(stderr, "kernel_launch: unexpected problem (n_in %d out %d ws %zu)\n", n_in, out_size, ws_size); grid = -1; return; }
        int dev = 0, cus = 0, per_cu = 0;
        if (hipGetDevice(&dev) != hipSuccess || hipDeviceGetAttribute(&cus, hipDeviceAttributeMultiprocessorCount, dev) != hipSuccess) { grid = -1; return; }
        if (hipFuncSetAttribute((const void*)mega, hipFuncAttributeMaxDynamicSharedMemorySize, LDS_BYTES) != hipSuccess) { fprintf(stderr, "kernel_launch: hipFuncSetAttribute failed\n"); grid = -1; return; }
        if (hipOccupancyMaxActiveBlocksPerMultiprocessor(&per_cu, (const void*)mega, NWAVES * 64, LDS_BYTES) != hipSuccess || per_cu < 1) { fprintf(stderr, "kernel_launch: occupancy query says %d blocks per CU\n", per_cu); }
        (void)hipGetLastError();
        grid = cus;
    }
    if (grid < 0) return;
    hipMemsetAsync((char*)d_ws + WS_CTL, 0, 1 * MiB, stream);
    MArgs a{};
    for (int i = 0; i < 20; ++i) a.p.in[i] = (const float*)d_in[i];
    a.p.out = (float*)d_out; a.p.ws = (unsigned char*)d_ws;
#if MK_CUTS
    for (int ph = 0; ph < N_PHASES; ++ph) { a.ph_lo = ph; a.ph_hi = ph + 1; a.li = ph; a.pad = 0;
        void* args[] = {&a};
        hipLaunchCooperativeKernel((const void*)mega, dim3(grid), dim3(NWAVES * 64), args, LDS_BYTES, stream); }
#else
    a.ph_lo = 0; a.ph_hi = N_PHASES; a.li = 0; a.pad = 0;
    void* args[] = {&a};
    hipError_t e = hipLaunchCooperativeKernel((const void*)mega, dim3(grid), dim3(NWAVES * 64), args, LDS_BYTES, stream);
    if (e != hipSuccess) fprintf(stderr, "kernel_launch: cooperative launch failed: %s (grid %d)\n", hipGetErrorString(e), grid);
#endif
}
```

```cpp
#include <hip/hip_runtime.h>
#include <cstdint>
#include <cstdio>

#define LAS __attribute__((address_space(3)))
typedef unsigned short bf16_t;
typedef short bf16x8 __attribute__((ext_vector_type(8)));
typedef float f32x4 __attribute__((ext_vector_type(4)));
typedef float f32x16 __attribute__((ext_vector_type(16)));
typedef unsigned u32x4 __attribute__((ext_vector_type(4)));
typedef unsigned u32x2 __attribute__((ext_vector_type(2)));

constexpr int SEQ = 16384, DM = 1024, NMEM = 256, DFF = 2816;
constexpr int IN_COLS = 3080;
constexpr int NQKV = 3072;
constexpr int NGU = 2 * DFF;
constexpr float RMS_EPS = 1e-6f;
constexpr float LOG2E = 1.4426950408889634f;
constexpr float C2 = 0.125f * LOG2E;
constexpr int BT_STRIDE = 132;
constexpr int CW_KN2 = 1024;
constexpr int CW_QN2 = 1088;
constexpr int CW_QUEUE = 3200;

constexpr size_t MiB = 1u << 20;
constexpr size_t WS_CTL = 0;
constexpr size_t WS_WIN = 1 * MiB;
constexpr size_t WS_WOUT = 7 * MiB;
constexpr size_t WS_WXQ = 9 * MiB;
constexpr size_t WS_WXO = 9 * MiB + 512 * 1024;
constexpr size_t WS_WGU = 10 * MiB;
constexpr size_t WS_WDN = 21 * MiB;
constexpr size_t WS_QKV = 28 * MiB;
constexpr size_t WS_QX = 28 * MiB;
constexpr size_t WS_OX = 36 * MiB;
constexpr size_t WS_HMID = 28 * MiB;
constexpr size_t WS_H1 = 124 * MiB;
constexpr size_t WS_H3 = 124 * MiB;
constexpr size_t WS_O = 156 * MiB;
constexpr size_t WS_H2 = 156 * MiB;
constexpr size_t WS_Y = 188 * MiB;
constexpr size_t WS_LOGF = 252 * MiB;
constexpr size_t WS_C = 252 * MiB + 512 * 1024;
constexpr size_t WS_KMEM = 253 * MiB;
constexpr size_t WS_VMEM = 253 * MiB + 128 * 1024;
constexpr size_t WS_BTAB = 253 * MiB + 256 * 1024;
constexpr size_t WS_DILTMP = 188 * MiB;
constexpr size_t WS_DLSE = 253 * MiB + 512 * 1024;
constexpr size_t WS_END = 256 * MiB;

__device__ __forceinline__ unsigned f2bf(float f) { unsigned u = __float_as_uint(f); return (u + 0x7fffu + ((u >> 16) & 1u)) >> 16; }
__device__ __forceinline__ unsigned pk2(float lo, float hi) { return f2bf(lo) | (f2bf(hi) << 16); }
__device__ __forceinline__ float bf2f(bf16_t b) { return __uint_as_float(((unsigned)b) << 16); }
__device__ __forceinline__ float wave_sum(float v) {
#pragma unroll
    for (int o = 1; o < 64; o <<= 1) v += __shfl_xor(v, o);
    return v;
}
__device__ __forceinline__ int t5_bucket(int dist) {
    if (dist < 16) return dist;
    int b = 16;
    b += dist >= 22; b += dist >= 30; b += dist >= 40; b += dist >= 54; b += dist >= 73; b += dist >= 99; b += dist >= 134; b += dist >= 182;
    b += dist >= 246; b += dist >= 332; b += dist >= 450; b += dist >= 609; b += dist >= 825; b += dist >= 1117; b += dist >= 1513;
    return b;
}

struct Ptrs {
    const float* in[20];
    float* out;
    unsigned char* ws;
};

__device__ __forceinline__ void p0_transpose_item(const float* W, int ldw, int scol0, bf16_t* WT, int ldt, int drow0, int k0, LAS float* scr, int lane) {
#pragma unroll 8
    for (int i = 0; i < 32; ++i) { const int kk = 2 * i + (lane >> 5); scr[kk * 33 + (lane & 31)] = W[(size_t)(k0 + kk) * ldw + scol0 + (lane & 31)]; }
    asm volatile("s_waitcnt lgkmcnt(0)" ::: "memory");
    const int c = lane & 7;
#pragma unroll
    for (int j = 0; j < 4; ++j) { const int n = (lane >> 3) + 8 * j; const LAS float* s = scr + (8 * c) * 33 + n;
        u32x4 o; o.x = pk2(s[0 * 33], s[1 * 33]); o.y = pk2(s[2 * 33], s[3 * 33]); o.z = pk2(s[4 * 33], s[5 * 33]); o.w = pk2(s[6 * 33], s[7 * 33]);
        *(u32x4*)(WT + (size_t)(drow0 + n) * ldt + k0 + 8 * c) = o; }
    asm volatile("s_waitcnt lgkmcnt(0)" ::: "memory");
}

__device__ __forceinline__ void p0_weights(const Ptrs& P, LAS float* scr, int gw, int ngw, int lane) {
    unsigned char* ws = P.ws;
    bf16_t* Win = (bf16_t*)(ws + WS_WIN); bf16_t* Wout = (bf16_t*)(ws + WS_WOUT); bf16_t* Wxq = (bf16_t*)(ws + WS_WXQ); bf16_t* Wxo = (bf16_t*)(ws + WS_WXO);
    bf16_t* Wgu = (bf16_t*)(ws + WS_WGU); bf16_t* Wdn = (bf16_t*)(ws + WS_WDN);
    constexpr int I_IN = (DM / 64) * (1536 / 32);
    constexpr int I_OUT = (DM / 64) * (DM / 32);
    constexpr int I_XQ = (DM / 64) * (256 / 32);
    constexpr int I_XO = (256 / 64) * (DM / 32);
    constexpr int I_G = (DM / 64) * (DFF / 32);
    constexpr int I_DN = (DFF / 64) * (DM / 32);
    constexpr int NITEMS = 2 * I_IN + I_OUT + I_XQ + I_XO + 2 * I_G + I_DN;
    for (int it = gw; it < NITEMS; it += ngw) {
        int r = it;
        if (r < I_IN) { const int nb = r % 48, kb = r / 48; p0_transpose_item(P.in[3], IN_COLS, 32 * nb, Win, DM, 32 * nb, 64 * kb, scr, lane); continue; } r -= I_IN;
        if (r < I_IN) { const int nb = r % 48, kb = r / 48; p0_transpose_item(P.in[3], IN_COLS, 1544 + 32 * nb, Win, DM, 1536 + 32 * nb, 64 * kb, scr, lane); continue; } r -= I_IN;
        if (r < I_OUT) { const int nb = r % 32, kb = r / 32; p0_transpose_item(P.in[6], DM, 32 * nb, Wout, DM, 32 * nb, 64 * kb, scr, lane); continue; } r -= I_OUT;
        if (r < I_XQ) { const int nb = r % 8, kb = r / 8; p0_transpose_item(P.in[10], 256, 32 * nb, Wxq, DM, 32 * nb, 64 * kb, scr, lane); continue; } r -= I_XQ;
        if (r < I_XO) { const int nb = r % 32, kb = r / 32; p0_transpose_item(P.in[13], DM, 32 * nb, Wxo, 256, 32 * nb, 64 * kb, scr, lane); continue; } r -= I_XO;
        if (r < I_G) { const int nb = r % 88, kb = r / 88; const int n0 = 32 * nb; p0_transpose_item(P.in[16], DFF, n0, Wgu, DM, (n0 >> 7) * 256 + (n0 & 127), 64 * kb, scr, lane); continue; } r -= I_G;
        if (r < I_G) { const int nb = r % 88, kb = r / 88; const int n0 = 32 * nb; p0_transpose_item(P.in[17], DFF, n0, Wgu, DM, (n0 >> 7) * 256 + 128 + (n0 & 127), 64 * kb, scr, lane); continue; } r -= I_G;
        { const int nb = r % 32, kb = r / 32; p0_transpose_item(P.in[18], DM, 32 * nb, Wdn, DFF, 32 * nb, 64 * kb, scr, lane); }
    }
}

__device__ __forceinline__ void p0_row(const Ptrs& P, int m, const LAS float* wg, int lane) {
    const f32x4* xr = (const f32x4*)(P.in[0] + (size_t)m * DM) + lane;
    const f32x4* gr = (const f32x4*)P.in[2] + lane;
    f32x4 v[4]; float ss = 0.f;
#pragma unroll
    for (int j = 0; j < 4; ++j) { v[j] = xr[64 * j]; ss += (v[j].x * v[j].x + v[j].y * v[j].y) + (v[j].z * v[j].z + v[j].w * v[j].w); }
    const float rstd = 1.0f / sqrtf(wave_sum(ss) * (1.0f / DM) + RMS_EPS);
#pragma unroll
    for (int j = 0; j < 4; ++j) { const f32x4 g = gr[64 * j]; v[j] = v[j] * rstd * g; }
    unsigned long long* o8 = (unsigned long long*)((bf16_t*)(P.ws + WS_H1) + (size_t)m * DM) + lane;
#pragma unroll
    for (int j = 0; j < 4; ++j) o8[64 * j] = (unsigned long long)pk2(v[j].x, v[j].y) | ((unsigned long long)pk2(v[j].z, v[j].w) << 32);
    float gs[8];
#pragma unroll
    for (int c = 0; c < 8; ++c) { float a = 0.f;
#pragma unroll
        for (int j = 0; j < 4; ++j) { const f32x4 w = *(const LAS f32x4*)(wg + c * 1024 + 256 * j + 4 * lane); a += (v[j].x * w.x + v[j].y * w.y) + (v[j].z * w.z + v[j].w * w.w); }
        gs[c] = wave_sum(a); }
    if (lane < 8) {
        float z = 0.f;
#pragma unroll
        for (int c = 0; c < 8; ++c) z = (lane == c) ? gs[c] : z;
        z += P.in[4][lane];
        const float lf = (z >= 0.f) ? -log1pf(expf(-z)) : (z - log1pf(expf(z)));
        ((float*)(P.ws + WS_LOGF))[(size_t)lane * SEQ + m] = lf;
    }
}

__device__ __forceinline__ void p0_memkv_unit(const Ptrs& P, int unit, LAS float* lds, int tid) {
    const int rb = unit >> 4, cb = unit & 15, wave = tid >> 6, lane = tid & 63;
    const float* W = cb < 8 ? P.in[11] : P.in[12]; const int c0 = (cb & 7) * 32;
    bf16_t* Out = (bf16_t*)(P.ws + (cb < 8 ? WS_KMEM : WS_VMEM));
#pragma unroll
    for (int rr = 0; rr < 2; ++rr) { const int r = 2 * wave + rr;
        const f32x4* xr = (const f32x4*)(P.in[1] + (size_t)(16 * rb + r) * DM) + lane; const f32x4* gr = (const f32x4*)P.in[9] + lane;
        f32x4 v[4]; float ss = 0.f;
#pragma unroll
        for (int j = 0; j < 4; ++j) { v[j] = xr[64 * j]; ss += (v[j].x * v[j].x + v[j].y * v[j].y) + (v[j].z * v[j].z + v[j].w * v[j].w); }
        const float rstd = 1.0f / sqrtf(wave_sum(ss) * (1.0f / DM) + RMS_EPS);
#pragma unroll
        for (int j = 0; j < 4; ++j) { const f32x4 g = gr[64 * j]; *(LAS f32x4*)(lds + r * 1024 + 256 * j + 4 * lane) = v[j] * rstd * g; } }
    __syncthreads();
    const int col = lane & 31, kh = lane >> 5, kbase = wave * 128 + kh * 64;
    float acc[16];
#pragma unroll
    for (int r = 0; r < 16; ++r) acc[r] = 0.f;
#pragma unroll 2
    for (int i = 0; i < 64; i += 4) {
        const float w0 = W[(size_t)(kbase + i) * 256 + c0 + col], w1 = W[(size_t)(kbase + i + 1) * 256 + c0 + col];
        const float w2 = W[(size_t)(kbase + i + 2) * 256 + c0 + col], w3 = W[(size_t)(kbase + i + 3) * 256 + c0 + col];
#pragma unroll
        for (int r = 0; r < 16; ++r) { const f32x4 hv = *(const LAS f32x4*)(lds + r * 1024 + kbase + i); acc[r] += (hv.x * w0 + hv.y * w1) + (hv.z * w2 + hv.w * w3); }
    }
    __syncthreads();
#pragma unroll
    for (int r = 0; r < 16; ++r) lds[((wave * 2 + kh) * 16 + r) * 32 + col] = acc[r];
    __syncthreads();
    { float s = 0.f;
#pragma unroll
      for (int p = 0; p < 16; ++p) s += lds[(p * 16 + (tid >> 5)) * 32 + (tid & 31)];
      const int key = 16 * rb + (tid >> 5), col = c0 + (tid & 31);
      if (cb < 8) Out[(size_t)key * 256 + col] = (bf16_t)f2bf(s);
      else { const int w16 = key & 15, pos = (key & ~15) + ((w16 >> 2) & 1) * 8 + ((w16 >> 3) << 2) + (w16 & 3);
          Out[(size_t)col * 256 + pos] = (bf16_t)f2bf(s); } }
    __syncthreads();
}

__device__ __forceinline__ void p0_prologue(const Ptrs& P, LAS unsigned char* ldsb, int vb, int nb) {
    const int tid = threadIdx.x, lane = tid & 63, wave = tid >> 6;
    LAS float* lds = (LAS float*)ldsb;
    for (int u = vb; u < 256; u += nb) p0_memkv_unit(P, u, lds, tid);
    for (int i = vb * 512 + tid; i < 3 * 8 * 129; i += nb * 512) { const int j = i % 129, ph = i / 129, h = ph & 7, p = ph >> 3; const int dil = p == 0 ? 1 : (p == 1 ? 4 : 16);
        ((float*)(P.ws + WS_BTAB))[ph * BT_STRIDE + j] = P.in[5][t5_bucket(j * dil) * 8 + h] * LOG2E; }
    for (int i = tid; i < 8 * 1024; i += 512) { const int k = i >> 3, c = i & 7; lds[c * 1024 + k] = P.in[3][(size_t)k * IN_COLS + 1536 + c]; }
    __syncthreads();
    const int gw = vb * 8 + wave, ngw = nb * 8;
    for (int m = gw; m < SEQ; m += ngw) p0_row(P, m, lds, lane);
    p0_weights(P, lds + 8192 + wave * (64 * 33), gw, ngw, lane);
}

constexpr int P0_LDS = 65536 + 8 * 64 * 33 * 4;


__device__ __forceinline__ void cumsum_head(const Ptrs& P, int h, LAS unsigned char* ldsb) {
    const int tid = threadIdx.x;
    LAS double* sd = (LAS double*)ldsb;
    const float* lf = (const float*)(P.ws + WS_LOGF) + (size_t)h * SEQ + tid * 32;
    float* cc = (float*)(P.ws + WS_C) + (size_t)h * SEQ + tid * 32;
    f32x4 v[8]; double s = 0.0;
#pragma unroll
    for (int i = 0; i < 8; ++i) { v[i] = ((const f32x4*)lf)[i]; s += (double)v[i].x + (double)v[i].y + (double)v[i].z + (double)v[i].w; }
    sd[tid] = s;
    __syncthreads();
    for (int off = 1; off < 512; off <<= 1) { double t = (tid >= off) ? sd[tid - off] : 0.0; __syncthreads(); sd[tid] += t; __syncthreads(); }
    double run = (tid > 0) ? sd[tid - 1] : 0.0;
#pragma unroll
    for (int i = 0; i < 8; ++i) { f32x4 o; run += (double)v[i].x; o.x = (float)run; run += (double)v[i].y; o.y = (float)run; run += (double)v[i].z; o.z = (float)run; run += (double)v[i].w; o.w = (float)run; ((f32x4*)cc)[i] = o; }
    __syncthreads();
}


namespace pg8 {
#define PG8_LAS __attribute__((address_space(3)))
typedef unsigned short bf16_t;
typedef short bf16x8 __attribute__((ext_vector_type(8)));
typedef float f32x4 __attribute__((ext_vector_type(4)));
typedef unsigned u32x4 __attribute__((ext_vector_type(4)));
constexpr int BM = 256, BK = 64, HALF = 128, HTB = HALF * BK * 2  , STAGE_BYTES = 8 * HTB, NXCD = 8, WGM = 8;

__host__ __device__ __forceinline__ int lds_byte(int r, int c) { const int st = (r >> 4) * 2 + (c >> 5), rr = r & 15, cc = c & 31, ob = rr * 64 + cc * 2; return st * 1024 + (ob ^ (((ob >> 9) & 1) << 5)); }
__host__ __device__ __forceinline__ void stage_rc(int b, int& R, int& C) { const int st = b / 1024, sb = b % 1024, swz = sb ^ (((sb >> 9) & 1) << 5); R = (st >> 1) * 16 + swz / 64; C = (st & 1) * 32 + (swz % 64) / 2; }
__host__ __device__ __forceinline__ int perm32(int rho) { const int n = rho >> 4, i = rho & 15; return 8 * (i >> 2) + 4 * n + (i & 3); }

struct Unit { int pm, pn; };
struct Gemm { const bf16_t* A; const bf16_t* Bt; int M, N, K; };

struct StaticOrder {
    int nM, nN, nwg, G, c;
    __host__ __device__ void init(int M, int N, int G_, int c_) { nM = M / BM; nN = N / BM; nwg = nM * nN; G = G_; c = c_; }
    __host__ __device__ bool next(int i, Unit& u) const {
        const long L = (long)i * G + c; if (L >= nwg) return false;
        int wgid = (int)L; { const int q = nwg / NXCD, r = nwg % NXCD, xcd = wgid % NXCD, off = wgid / NXCD; wgid = (xcd < r ? xcd * (q + 1) : r * (q + 1) + (xcd - r) * q) + off; }
        const int nig = WGM * nN, gid = wgid / nig, fm = gid * WGM, gsz = (nM - fm) < WGM ? (nM - fm) : WGM;
        u.pm = fm + ((wgid % nig) % gsz); u.pn = (wgid % nig) / gsz; return true;
    }
    __device__ __forceinline__ void a_ready(const Unit&) const {}
    __device__ __forceinline__ void done(const Unit&) const {}
};

__device__ __forceinline__ unsigned cvt_pk_bf16(float lo, float hi) { unsigned r; asm volatile("v_cvt_pk_bf16_f32 %0, %1, %2" : "=v"(r) : "v"(lo), "v"(hi)); return r; }
typedef float f32x2 __attribute__((ext_vector_type(2)));
struct EpiQKVp {
    static constexpr bool PERM = true, AFTER_DRAIN = false;
    bf16_t* O; unsigned* ctl;
    __device__ __forceinline__ void operator()(const f32x4 (&acc)[2][2][4][2], const Unit& u, int wr, int wc, int fr, int fq) const {
        const int row0 = u.pm * BM + wr * 64 + fr, col0 = u.pn * BM + wc * 32 + 8 * fq;
        const float sc = (u.pn < 2 || u.pn == 6 || u.pn == 7) ? C2 : 1.f;
        if (u.pn < 4) {
            float mx[2] = {0.f, 0.f};
#pragma unroll
            for (int ai = 0; ai < 2; ++ai)
#pragma unroll
                for (int m = 0; m < 4; ++m)
#pragma unroll
                    for (int bj = 0; bj < 2; ++bj) { const f32x4 a = acc[ai][bj][m][0] * sc, b = acc[ai][bj][m][1] * sc;
                        float q2 = (a[0] * a[0] + a[1] * a[1]) + (a[2] * a[2] + a[3] * a[3]) + (b[0] * b[0] + b[1] * b[1]) + (b[2] * b[2] + b[3] * b[3]);
                        q2 += __shfl_xor(q2, 16); q2 += __shfl_xor(q2, 32); mx[bj] = fmaxf(mx[bj], q2); }
#pragma unroll
            for (int bj = 0; bj < 2; ++bj) { float t = mx[bj];
                t = fmaxf(t, __shfl_xor(t, 1)); t = fmaxf(t, __shfl_xor(t, 2)); t = fmaxf(t, __shfl_xor(t, 4)); t = fmaxf(t, __shfl_xor(t, 8));
                if (fr == 0 && fq == 0) { const int head = (u.pn & 1) * 4 + bj * 2 + (wc >> 1), half = wc & 1;
                    unsigned* w = (u.pn < 2) ? ctl + CW_QN2 + (head * 64 + u.pm) * 2 + half : ctl + CW_KN2 + head * 2 + half;
                    atomicMax(w, __float_as_uint(t)); } }
        }
#pragma unroll
        for (int ai = 0; ai < 2; ++ai)
#pragma unroll
            for (int m = 0; m < 4; ++m) { bf16_t* rowp = O + (size_t)(row0 + ai * HALF + m * 16) * NQKV + col0;
#pragma unroll
                for (int bj = 0; bj < 2; ++bj) { const f32x4 v0 = acc[ai][bj][m][0] * sc, v1 = acc[ai][bj][m][1] * sc;
                    u32x4 w; w.x = cvt_pk_bf16(v0[0], v0[1]); w.y = cvt_pk_bf16(v0[2], v0[3]); w.z = cvt_pk_bf16(v1[0], v1[1]); w.w = cvt_pk_bf16(v1[2], v1[3]);
                    *(u32x4*)(rowp + bj * HALF) = w; } }
    }
};
struct EpiBfp {
    static constexpr bool PERM = true, AFTER_DRAIN = false;
    bf16_t* O; int ldc; float sc;
    __device__ __forceinline__ void operator()(const f32x4 (&acc)[2][2][4][2], const Unit& u, int wr, int wc, int fr, int fq) const {
        const int row0 = u.pm * BM + wr * 64 + fr, col0 = u.pn * BM + wc * 32 + 8 * fq;
#pragma unroll
        for (int ai = 0; ai < 2; ++ai)
#pragma unroll
            for (int m = 0; m < 4; ++m) { bf16_t* rowp = O + (size_t)(row0 + ai * HALF + m * 16) * ldc + col0;
#pragma unroll
                for (int bj = 0; bj < 2; ++bj) { const f32x4 v0 = acc[ai][bj][m][0] * sc, v1 = acc[ai][bj][m][1] * sc;
                    u32x4 w; w.x = cvt_pk_bf16(v0[0], v0[1]); w.y = cvt_pk_bf16(v0[2], v0[3]); w.z = cvt_pk_bf16(v1[0], v1[1]); w.w = cvt_pk_bf16(v1[2], v1[3]);
                    *(u32x4*)(rowp + bj * HALF) = w; } }
    }
};
struct EpiSwiGLU {
    static constexpr bool PERM = true, AFTER_DRAIN = false;
    bf16_t* H;
    __device__ __forceinline__ void operator()(const f32x4 (&acc)[2][2][4][2], const Unit& u, int wr, int wc, int fr, int fq) const {
        const int row0 = u.pm * BM + wr * 64 + fr, col0 = u.pn * HALF + wc * 32 + 8 * fq;
#pragma unroll
        for (int ai = 0; ai < 2; ++ai)
#pragma unroll
            for (int m = 0; m < 4; ++m) { float h[8];
#pragma unroll
                for (int n = 0; n < 2; ++n)
#pragma unroll
                    for (int e = 0; e < 4; ++e) { const float g = acc[ai][0][m][n][e], up = acc[ai][1][m][n][e];
                        h[4 * n + e] = g * __builtin_amdgcn_rcpf(1.0f + __builtin_amdgcn_exp2f(-LOG2E * g)) * up; }
                u32x4 w; w.x = cvt_pk_bf16(h[0], h[1]); w.y = cvt_pk_bf16(h[2], h[3]); w.z = cvt_pk_bf16(h[4], h[5]); w.w = cvt_pk_bf16(h[6], h[7]);
                *(u32x4*)(H + (size_t)(row0 + ai * HALF + m * 16) * DFF + col0) = w; }
    }
};
struct EpiF32p {
    static constexpr bool PERM = false, AFTER_DRAIN = false;
    float* O; int ldc;
    __device__ __forceinline__ void operator()(const f32x4 (&acc)[2][2][4][2], const Unit& u, int wr, int wc, int fr, int fq) const {
        const int col0 = u.pn * BM + wc * 32 + 4 * fq;
#pragma unroll
        for (int ai = 0; ai < 2; ++ai)
#pragma unroll
            for (int m = 0; m < 4; ++m) { const size_t off = (size_t)(u.pm * BM + ai * HALF + wr * 64 + m * 16 + fr) * ldc + col0;
#pragma unroll
                for (int bj = 0; bj < 2; ++bj)
#pragma unroll
                    for (int n = 0; n < 2; ++n) *(f32x4*)(O + off + bj * HALF + n * 16) = acc[ai][bj][m][n]; }
    }
};
template <class Epi, class Sched, bool ALIGN_EPI = false, bool SP2 = false>
__device__ __forceinline__ void gemm_phase(PG8_LAS unsigned char* lds, const Gemm g, const Sched& S, const Epi& E) {
    const int tid = threadIdx.x, wid = __builtin_amdgcn_readfirstlane(tid >> 6), lane = tid & 63, wr = wid >> 2, wc = wid & 3, fr = lane & 15, fq = lane >> 4;
    const int K = g.K, nt = K / BK;
    unsigned voffA[2], voffB[2];
#pragma unroll
    for (int i = 0; i < 2; ++i) { int R, C; stage_rc(tid * 16 + i * 8192, R, C); const int Rb = Epi::PERM ? ((R & ~31) + perm32(R & 31)) : R;
        voffA[i] = (unsigned)(R * K + C) * 2u; voffB[i] = (unsigned)(Rb * K + C) * 2u; }
    const size_t kstep = (size_t)(BK * 2);
    const size_t hstep = (size_t)HALF * K * 2;
    const size_t tstep = 2 * hstep;
    const unsigned ldsw = (unsigned)wid * 1024u;
    const int aoff = lds_byte(wr * 64 + fr, fq * 8), boff = lds_byte(wc * 32 + fr, fq * 8);
#define PG8_SA(b, h) (((b) * 2 + (h)) * HTB)
#define PG8_SB(b, h) ((4 + (b) * 2 + (h)) * HTB)
#define PG8_STAGE(bufoff, gbase, voff) do { _Pragma("unroll") for (int _i = 0; _i < 2; ++_i) \
        __builtin_amdgcn_global_load_lds((const unsigned*)((const char*)(gbase) + (voff)[_i]), (PG8_LAS unsigned*)(lds + (bufoff) + ldsw + _i * 8192), 16, 0, 0); } while (0)
#define PG8_LDA(dst, b, h) do { _Pragma("unroll") for (int m = 0; m < 4; ++m) _Pragma("unroll") for (int k = 0; k < 2; ++k) dst[m][k] = *(const PG8_LAS bf16x8*)(lds + PG8_SA(b, h) + aoff + m * 2048 + k * 1024); } while (0)
#define PG8_LDB(dst, b, h) do { _Pragma("unroll") for (int n = 0; n < 2; ++n) _Pragma("unroll") for (int k = 0; k < 2; ++k) dst[n][k] = *(const PG8_LAS bf16x8*)(lds + PG8_SB(b, h) + boff + n * 2048 + k * 1024); } while (0)
#define PG8_MMA(ai, bj, At, Bt) do { __builtin_amdgcn_s_setprio(1); _Pragma("unroll") for (int m = 0; m < 4; ++m) _Pragma("unroll") for (int n = 0; n < 2; ++n) _Pragma("unroll") for (int k = 0; k < 2; ++k) \
        acc[ai][bj][m][n] = __builtin_amdgcn_mfma_f32_16x16x32_bf16(Bt[n][k], At[m][k], acc[ai][bj][m][n], 0, 0, 0); __builtin_amdgcn_s_setprio(0); } while (0)
#define PG8_WAIT_V(n) asm volatile("s_waitcnt vmcnt(" #n ")" ::: "memory")
#define PG8_WAIT_L(n) asm volatile("s_waitcnt lgkmcnt(" #n ")" ::: "memory")
#define PG8_BAR __builtin_amdgcn_s_barrier()
#define PG8_SCHED __builtin_amdgcn_sched_barrier(0)
    Unit cur, nxt; int ui = 0;
    if (!S.next(0, cur)) return;
    f32x4 acc[2][2][4][2];
#pragma unroll
    for (int a = 0; a < 2; ++a)
#pragma unroll
        for (int b = 0; b < 2; ++b)
#pragma unroll
            for (int m = 0; m < 4; ++m)
#pragma unroll
                for (int n = 0; n < 2; ++n) acc[a][b][m][n] = (f32x4){0.f, 0.f, 0.f, 0.f};
    bf16x8 At[4][2], B0[2][2], B1[2][2];
    const char* cA = (const char*)g.A + (size_t)cur.pm * tstep; const char* cB = (const char*)g.Bt + (size_t)cur.pn * tstep;
    S.a_ready(cur);
    if constexpr (SP2) {
        PG8_STAGE(PG8_SB(0, 0), cB, voffB); PG8_STAGE(PG8_SB(0, 1), cB + hstep, voffB); PG8_STAGE(PG8_SA(0, 0), cA, voffA); PG8_STAGE(PG8_SA(0, 1), cA + hstep, voffA);
        if (wr == 1) PG8_BAR;
        PG8_WAIT_V(2); PG8_BAR;
        PG8_STAGE(PG8_SB(1, 0), cB + kstep, voffB); PG8_STAGE(PG8_SA(1, 0), cA + kstep, voffA); PG8_STAGE(PG8_SB(1, 1), cB + hstep + kstep, voffB);
        PG8_WAIT_V(6); PG8_BAR;
    } else {
        PG8_STAGE(PG8_SB(0, 0), cB, voffB); PG8_STAGE(PG8_SA(0, 0), cA, voffA); PG8_STAGE(PG8_SB(0, 1), cB + hstep, voffB); PG8_STAGE(PG8_SA(0, 1), cA + hstep, voffA);
        if (wr == 1) PG8_BAR;
        PG8_WAIT_V(4); PG8_BAR;
        PG8_STAGE(PG8_SB(1, 0), cB + kstep, voffB); PG8_STAGE(PG8_SA(1, 0), cA + kstep, voffA); PG8_STAGE(PG8_SB(1, 1), cB + hstep + kstep, voffB);
        PG8_WAIT_V(6); PG8_BAR;
    }
    for (;;) {
        const bool has_next = S.next(ui + 1, nxt);
        const char* nA = has_next ? (const char*)g.A + (size_t)nxt.pm * tstep : cA; const char* nB = has_next ? (const char*)g.Bt + (size_t)nxt.pn * tstep : cB;
        for (int t = 0; t < nt; t += 2) {
            const bool last = (t == nt - 2);
            const char* a1 = cA + (size_t)(t + 1) * kstep;
            const char* a2 = last ? nA : cA + (size_t)(t + 2) * kstep; const char* b2 = last ? nB : cB + (size_t)(t + 2) * kstep;
            const char* a3 = a2 + kstep; const char* b3 = b2 + kstep;
            if (last && has_next) S.a_ready(nxt);
            if constexpr (SP2) {
            PG8_LDB(B0, 0, 0); PG8_LDB(B1, 0, 1); PG8_SCHED; PG8_LDA(At, 0, 0); PG8_STAGE(PG8_SA(1, 1), a1 + hstep, voffA);
            PG8_WAIT_V(8); PG8_WAIT_L(0); PG8_BAR; PG8_MMA(0, 0, At, B0); PG8_MMA(0, 1, At, B1); PG8_BAR; PG8_SCHED;
            PG8_LDA(At, 0, 1); PG8_STAGE(PG8_SB(0, 0), b2, voffB); PG8_STAGE(PG8_SB(0, 1), b2 + hstep, voffB); PG8_STAGE(PG8_SA(0, 0), a2, voffA);
            PG8_WAIT_V(8); PG8_WAIT_L(0); PG8_BAR; PG8_MMA(1, 0, At, B0); PG8_MMA(1, 1, At, B1); PG8_BAR; PG8_SCHED;
            PG8_LDB(B0, 1, 0); PG8_LDB(B1, 1, 1); PG8_SCHED; PG8_LDA(At, 1, 0); PG8_STAGE(PG8_SA(0, 1), a2 + hstep, voffA);
            PG8_WAIT_V(8); PG8_WAIT_L(0); PG8_BAR; PG8_MMA(0, 0, At, B0); PG8_MMA(0, 1, At, B1); PG8_BAR; PG8_SCHED;
            PG8_LDA(At, 1, 1); PG8_STAGE(PG8_SB(1, 0), b3, voffB); PG8_STAGE(PG8_SB(1, 1), b3 + hstep, voffB); PG8_STAGE(PG8_SA(1, 0), a3, voffA);
            PG8_WAIT_V(8); PG8_WAIT_L(0); PG8_BAR; PG8_MMA(1, 0, At, B0); PG8_MMA(1, 1, At, B1); PG8_BAR; PG8_SCHED;
            } else {
            PG8_LDB(B0, 0, 0); PG8_SCHED; PG8_LDA(At, 0, 0); PG8_STAGE(PG8_SA(1, 1), a1 + hstep, voffA);
            PG8_WAIT_L(8); PG8_BAR; PG8_WAIT_L(0); PG8_MMA(0, 0, At, B0); PG8_BAR; PG8_SCHED;
            PG8_LDB(B1, 0, 1); PG8_STAGE(PG8_SB(0, 0), b2, voffB);
            PG8_BAR; PG8_WAIT_L(0); PG8_MMA(0, 1, At, B1); PG8_BAR;
            PG8_LDA(At, 0, 1); PG8_STAGE(PG8_SA(0, 0), a2, voffA);
            PG8_BAR; PG8_WAIT_L(0); PG8_MMA(1, 0, At, B0); PG8_BAR; PG8_SCHED;
            PG8_STAGE(PG8_SB(0, 1), b2 + hstep, voffB);
            PG8_WAIT_V(6); PG8_BAR; PG8_MMA(1, 1, At, B1); PG8_BAR;
            PG8_LDB(B0, 1, 0); PG8_SCHED; PG8_LDA(At, 1, 0); PG8_STAGE(PG8_SA(0, 1), a2 + hstep, voffA);
            PG8_WAIT_L(8); PG8_BAR; PG8_WAIT_L(0); PG8_MMA(0, 0, At, B0); PG8_BAR; PG8_SCHED;
            PG8_LDB(B1, 1, 1); PG8_STAGE(PG8_SB(1, 0), b3, voffB);
            PG8_BAR; PG8_WAIT_L(0); PG8_MMA(0, 1, At, B1); PG8_BAR;
            PG8_LDA(At, 1, 1); PG8_STAGE(PG8_SA(1, 0), a3, voffA);
            PG8_BAR; PG8_WAIT_L(0); PG8_MMA(1, 0, At, B0); PG8_BAR; PG8_SCHED;
            PG8_STAGE(PG8_SB(1, 1), b3 + hstep, voffB);
            PG8_WAIT_V(6); PG8_BAR; PG8_MMA(1, 1, At, B1); PG8_BAR;
            }
        }
        if constexpr (ALIGN_EPI) { if (wr == 0) PG8_BAR; }
        if constexpr (!Epi::AFTER_DRAIN) { E(acc, cur, wr, wc, fr, fq); S.done(cur); }
        if (!has_next) break;
#pragma unroll
        for (int a = 0; a < 2; ++a)
#pragma unroll
            for (int b = 0; b < 2; ++b)
#pragma unroll
                for (int m = 0; m < 4; ++m)
#pragma unroll
                    for (int n = 0; n < 2; ++n) acc[a][b][m][n] = (f32x4){0.f, 0.f, 0.f, 0.f};
        cur = nxt; cA = nA; cB = nB; ++ui;
        if constexpr (ALIGN_EPI) { if (wr == 1) PG8_BAR; }
    }
    PG8_WAIT_V(0);
    if constexpr (!ALIGN_EPI) { if (wr == 0) PG8_BAR; }
    PG8_BAR;
    if constexpr (Epi::AFTER_DRAIN) { E.fused(acc, cur, wr, wc, fr, fq, lds, wid, lane); S.done(cur); }
#undef PG8_SA
#undef PG8_SB
#undef PG8_STAGE
#undef PG8_LDA
#undef PG8_LDB
#undef PG8_MMA
#undef PG8_WAIT_V
#undef PG8_WAIT_L
#undef PG8_BAR
#undef PG8_SCHED
}
}

#define XB_TMO      128
#define XB_XCNT(j)  (256  + 64 * (j))
#define XB_XSUB(j)  (1280 + 64 * (j))
#define XB_XGEN(j)  (2304 + 64 * (j))
#define XB_TOP      3328
#define XB_TOPGEN   3392
#define XCD_BAR_WORDS 3456
#define XB_SPIN_CAP (1u << 18)

__device__ __forceinline__ unsigned xb_ld(unsigned* p)              { return __hip_atomic_load(p, __ATOMIC_RELAXED, __HIP_MEMORY_SCOPE_AGENT); }
__device__ __forceinline__ unsigned xb_add(unsigned* p, unsigned v) { return __hip_atomic_fetch_add(p, v, __ATOMIC_RELAXED, __HIP_MEMORY_SCOPE_AGENT); }
__device__ __forceinline__ unsigned xb_xcc_id() { return (unsigned)__builtin_amdgcn_s_getreg((3 << 11) | 20) & 0xFu; }
#define XB_SPIN(cond, bar) do { unsigned _sp = 0; while (cond) { __builtin_amdgcn_s_sleep(1); \
    if ((++_sp & 255u) == 0u) { if (xb_ld(&(bar)[XB_TMO])) break; if (_sp > XB_SPIN_CAP) { atomicAdd(&(bar)[XB_TMO], 1u); break; } } } } while (0)

struct XcdBarrier {
    unsigned* bar; unsigned x;
    volatile LAS unsigned* st;
};

__device__ __forceinline__ XcdBarrier xcd_barrier_post(unsigned* bar, volatile LAS unsigned* st) {
    XcdBarrier b; b.bar = bar; b.x = xb_xcc_id(); b.st = st;
    if (threadIdx.x == 0) (void)xb_add(&bar[XB_XCNT(b.x)], 1u);
    return b;
}
__device__ __forceinline__ void xcd_barrier_complete(unsigned* bar, unsigned x, unsigned& nloc, unsigned& nx) {
    const unsigned G = gridDim.x * gridDim.y * gridDim.z;
    unsigned sum, cnt, mine, sp = 0u;
    for (;;) {
        sum = 0u; cnt = 0u; mine = 0u;
#pragma unroll
        for (unsigned j = 0; j < 16; ++j) { const unsigned c = xb_ld(&bar[XB_XCNT(j)]); sum += c; cnt += (c > 0u) ? 1u : 0u; mine = (j == x) ? c : mine; }
        if (sum == G) break;
        __builtin_amdgcn_s_sleep(1);
        if ((++sp & 255u) == 0u) { if (xb_ld(&bar[XB_TMO])) break; if (sp > XB_SPIN_CAP) { atomicAdd(&bar[XB_TMO], 1u); break; } }
    }
    nloc = mine > 0u ? mine : 1u; nx = cnt > 0u ? cnt : 1u;
}

__device__ __forceinline__ void xcd_barrier(const XcdBarrier& b) {
    asm volatile("s_waitcnt vmcnt(0)" ::: "memory");
    __syncthreads();
    if (threadIdx.x == 0) {
        unsigned* bar = b.bar;
        __builtin_amdgcn_s_waitcnt(0);
        unsigned nloc = b.st[0], nx = b.st[1];
        if (nloc == 0u) { xcd_barrier_complete(bar, b.x, nloc, nx); b.st[0] = nloc; b.st[1] = nx; }
        const unsigned old = xb_add(&bar[XB_XSUB(b.x)], 1u);
        const unsigned gen = old / nloc;
        if (old + 1u == (gen + 1u) * nloc) {
            __builtin_amdgcn_fence(__ATOMIC_RELEASE, "agent");
            asm volatile("s_waitcnt vmcnt(0)" ::: "memory");
            const unsigned og = xb_add(&bar[XB_TOP], 1u);
            const unsigned tg = og / nx;
            if (og + 1u == (tg + 1u) * nx) xb_add(&bar[XB_TOPGEN], 1u);
            else XB_SPIN(xb_ld(&bar[XB_TOPGEN]) == tg, bar);
            __builtin_amdgcn_fence(__ATOMIC_ACQUIRE, "agent");
            xb_add(&bar[XB_XGEN(b.x)], 1u);
            asm volatile("s_waitcnt vmcnt(0)" ::: "memory");
        } else {
            XB_SPIN(xb_ld(&bar[XB_XGEN(b.x)]) == gen, bar);
            __builtin_amdgcn_fence(__ATOMIC_ACQUIRE, "agent");
            asm volatile("s_waitcnt vmcnt(0)" ::: "memory");
        }
    }
    __syncthreads();
}

struct RowAttn {
    float q[64], o[64], m, l;
    __device__ __forceinline__ void init(const bf16_t* qp) {
#pragma unroll
        for (int d = 0; d < 64; ++d) { q[d] = bf2f(qp[d]); o[d] = 0.f; } m = -INFINITY; l = 0.f; }
    __device__ __forceinline__ void key(const bf16_t* kp, const bf16_t* vp, float bias) {
        float s = 0.f;
#pragma unroll
        for (int d = 0; d < 64; d += 8) { const u32x4 kv = *(const u32x4*)(kp + d);
            s += q[d] * __uint_as_float(kv.x << 16) + q[d + 1] * __uint_as_float(kv.x & 0xffff0000u) + q[d + 2] * __uint_as_float(kv.y << 16) + q[d + 3] * __uint_as_float(kv.y & 0xffff0000u)
               + q[d + 4] * __uint_as_float(kv.z << 16) + q[d + 5] * __uint_as_float(kv.z & 0xffff0000u) + q[d + 6] * __uint_as_float(kv.w << 16) + q[d + 7] * __uint_as_float(kv.w & 0xffff0000u); }
        s += bias;
        const float mnew = fmaxf(m, s), alpha = exp2f(m - mnew), p = exp2f(s - mnew);
        l = l * alpha + p; m = mnew;
#pragma unroll
        for (int d = 0; d < 64; d += 8) { const u32x4 vv = *(const u32x4*)(vp + d);
            o[d] = o[d] * alpha + p * __uint_as_float(vv.x << 16); o[d + 1] = o[d + 1] * alpha + p * __uint_as_float(vv.x & 0xffff0000u);
            o[d + 2] = o[d + 2] * alpha + p * __uint_as_float(vv.y << 16); o[d + 3] = o[d + 3] * alpha + p * __uint_as_float(vv.y & 0xffff0000u);
            o[d + 4] = o[d + 4] * alpha + p * __uint_as_float(vv.z << 16); o[d + 5] = o[d + 5] * alpha + p * __uint_as_float(vv.z & 0xffff0000u);
            o[d + 6] = o[d + 6] * alpha + p * __uint_as_float(vv.w << 16); o[d + 7] = o[d + 7] * alpha + p * __uint_as_float(vv.w & 0xffff0000u); }
    }
    __device__ __forceinline__ void store(bf16_t* op) const { const float rl = 1.0f / l;
#pragma unroll
        for (int d = 0; d < 64; d += 2) *(unsigned*)(op + d) = pk2(o[d] * rl, o[d + 1] * rl); }
};
__device__ __forceinline__ void dil_unit_fwd(const Ptrs& P, int h, int st, LAS unsigned char* lds);
namespace fox {
typedef short s16x4 __attribute__((ext_vector_type(4)));
typedef short v4i16_t __attribute__((ext_vector_type(4)));
constexpr float NEG = -1.0e30f;
constexpr int LDS_K = 0, LDS_V = 16384, LDS_C = 32768, LDS_MISC = 33792;
__device__ __forceinline__ int crow(int r, int hi) { return (r & 3) + 8 * (r >> 2) + 4 * hi; }
__device__ __forceinline__ s16x4 vtr(const LAS unsigned char* p) { return __builtin_bit_cast(s16x4, __builtin_amdgcn_ds_read_tr16_b64_v4i16((LAS v4i16_t*)p)); }
__device__ __forceinline__ unsigned cvtpk(float lo, float hi) { typedef float f2 __attribute__((ext_vector_type(2))); typedef __bf16 b2 __attribute__((ext_vector_type(2)));
    f2 v = {lo, hi}; b2 b = __builtin_convertvector(v, b2); return __builtin_bit_cast(unsigned, b); }
__device__ __forceinline__ bf16x8 pack8(const f32x16& p, int s) {
    u32x4 w; w.x = cvtpk(p[8 * s], p[8 * s + 1]); w.y = cvtpk(p[8 * s + 2], p[8 * s + 3]); w.z = cvtpk(p[8 * s + 4], p[8 * s + 5]); w.w = cvtpk(p[8 * s + 6], p[8 * s + 7]);
    return __builtin_bit_cast(bf16x8, w); }

__device__ __forceinline__ void unit(const Ptrs& P, int h, int qb, int jlo, LAS unsigned char* lds) {
    const int tid = threadIdx.x, lane = tid & 63, wave = __builtin_amdgcn_readfirstlane(tid >> 6), r32 = lane & 31, hi = lane >> 5;
    const bf16_t* QKV = (const bf16_t*)(P.ws + WS_QKV);
    const bf16_t* Qh = QKV + h * 64; const bf16_t* Kh = QKV + 512 + h * 64; const bf16_t* Vh = QKV + 1024 + h * 64;
    const float* ch = (const float*)(P.ws + WS_C) + (size_t)h * SEQ;
    const int q0w = qb * 256 + wave * 32, q = q0w + r32, jhi = 4 * qb + 3;
    bf16x8 qr[4];
#pragma unroll
    for (int ds = 0; ds < 4; ++ds) qr[ds] = *(const bf16x8*)(Qh + (size_t)q * NQKV + ds * 16 + hi * 8);
    const float cq = ch[q] * LOG2E;
    const bf16_t* ksrc = Kh + (size_t)lane * NQKV + wave * 8;
    const bf16_t* vsrc = Vh + (size_t)(16 * (wave & 3) + (lane >> 2)) * NQKV + (wave >> 2) * 32 + (lane & 3) * 8;
    const int sdst = wave * 1024 + lane * 16;
    LAS float* Cb = (LAS float*)(lds + LDS_C);
    u32x4 kreg, vreg; float creg = 0.f;
#define FOX_LOAD(j) do { kreg = *(const u32x4*)(ksrc + (size_t)(j) * 64 * NQKV); vreg = *(const u32x4*)(vsrc + (size_t)(j) * 64 * NQKV); if (wave == 0) creg = ch[(j) * 64 + lane] * LOG2E; } while (0)
#define FOX_STORE(b) do { *(LAS u32x4*)(lds + LDS_K + (b) * 8192 + sdst) = kreg; *(LAS u32x4*)(lds + LDS_V + (b) * 8192 + sdst) = vreg; if (wave == 0) Cb[(b) * 64 + lane] = creg; } while (0)
    float m = NEG, l = 0.f;
    f32x16 o[2];
#pragma unroll
    for (int i = 0; i < 16; ++i) { o[0][i] = 0.f; o[1][i] = 0.f; }
    FOX_LOAD(jlo); FOX_STORE(0);
    for (int j = jlo; j <= jhi; ++j) {
        const int b = (j - jlo) & 1;
        __syncthreads();
        if (j < jhi) FOX_LOAD(j + 1);
        if (j * 64 <= q0w + 31) {
            const LAS unsigned char* kp = lds + LDS_K + b * 8192 + hi * 1024 + r32 * 16;
            f32x16 p0, p1;
#pragma unroll
            for (int i = 0; i < 16; ++i) { p0[i] = 0.f; p1[i] = 0.f; }
#pragma unroll
            for (int ds = 0; ds < 4; ++ds) { const bf16x8 k0 = *(const LAS bf16x8*)(kp + ds * 2048), k1 = *(const LAS bf16x8*)(kp + ds * 2048 + 512);
                p0 = __builtin_amdgcn_mfma_f32_32x32x16_bf16(k0, qr[ds], p0, 0, 0, 0); p1 = __builtin_amdgcn_mfma_f32_32x32x16_bf16(k1, qr[ds], p1, 0, 0, 0); }
            const LAS float* cb = Cb + b * 64 + 4 * hi;
#pragma unroll
            for (int g = 0; g < 4; ++g) { const f32x4 c0 = *(const LAS f32x4*)(cb + 8 * g), c1 = *(const LAS f32x4*)(cb + 32 + 8 * g);
#pragma unroll
                for (int e = 0; e < 4; ++e) { p0[4 * g + e] += cq - c0[e]; p1[4 * g + e] += cq - c1[e]; } }
            if (j * 64 + 63 > q0w) {
#pragma unroll
                for (int r = 0; r < 16; ++r) { const int kv = j * 64 + crow(r, hi); if (kv > q) p0[r] = NEG; if (kv + 32 > q) p1[r] = NEG; }
            }
            float rm = fmaxf(p0[0], p1[0]);
#pragma unroll
            for (int r = 1; r < 16; ++r) rm = fmaxf(rm, fmaxf(p0[r], p1[r]));
            rm = fmaxf(rm, __shfl_xor(rm, 32));
            const float mnew = fmaxf(m, rm), alpha = __builtin_amdgcn_exp2f(m - mnew);
            m = mnew;
            float rs = 0.f;
#pragma unroll
            for (int r = 0; r < 16; ++r) { p0[r] = __builtin_amdgcn_exp2f(p0[r] - mnew); p1[r] = __builtin_amdgcn_exp2f(p1[r] - mnew); rs += p0[r] + p1[r]; }
            l = l * alpha + rs;
#pragma unroll
            for (int i = 0; i < 16; ++i) { o[0][i] *= alpha; o[1][i] *= alpha; }
            bf16x8 pb[4]; pb[0] = pack8(p0, 0); pb[1] = pack8(p0, 1); pb[2] = pack8(p1, 0); pb[3] = pack8(p1, 1);
            const LAS unsigned char* vp = lds + LDS_V + b * 8192 + ((lane >> 4) & 1) * 32 + (lane & 3) * 8 + (4 * hi + ((lane & 15) >> 2)) * 64;
#pragma unroll
            for (int d0 = 0; d0 < 2; ++d0)
#pragma unroll
                for (int ks = 0; ks < 4; ++ks) { const s16x4 lo = vtr(vp + d0 * 4096 + ks * 1024), hh = vtr(vp + d0 * 4096 + ks * 1024 + 512);
                    const bf16x8 vf = (bf16x8){lo[0], lo[1], lo[2], lo[3], hh[0], hh[1], hh[2], hh[3]};
                    o[d0] = __builtin_amdgcn_mfma_f32_32x32x16_bf16(vf, pb[ks], o[d0], 0, 0, 0); }
        }
        if (j < jhi) FOX_STORE(b ^ 1);
    }
#undef FOX_LOAD
#undef FOX_STORE
    l += __shfl_xor(l, 32);
    const float rl = 1.0f / l;
    bf16_t* op = (bf16_t*)(P.ws + WS_O) + (size_t)q * DM + h * 64 + 4 * hi;
#pragma unroll
    for (int d0 = 0; d0 < 2; ++d0)
#pragma unroll
        for (int g = 0; g < 4; ++g) { u32x2 w; w.x = cvtpk(o[d0][4 * g] * rl, o[d0][4 * g + 1] * rl); w.y = cvtpk(o[d0][4 * g + 2] * rl, o[d0][4 * g + 3] * rl);
            *(u32x2*)(op + 32 * d0 + 8 * g) = w; }
    __syncthreads();
}
__device__ __forceinline__ int first_tile(const Ptrs& P, int h, int qb, LAS unsigned char* lds) {
    const unsigned* ctl = (const unsigned*)(P.ws + WS_CTL);
    const float* ch = (const float*)(P.ws + WS_C) + (size_t)h * SEQ;
    LAS unsigned* cnt = (LAS unsigned*)(lds + LDS_MISC);
    const int tid = threadIdx.x;
    const float qn2 = __uint_as_float(ctl[CW_QN2 + (h * 64 + qb) * 2]) + __uint_as_float(ctl[CW_QN2 + (h * 64 + qb) * 2 + 1]);
    const float kn2 = __uint_as_float(ctl[CW_KN2 + h * 2]) + __uint_as_float(ctl[CW_KN2 + h * 2 + 1]);
    const float B = sqrtf(qn2 * kn2) * 1.01f;
    const float cthr = ch[qb * 256] * LOG2E + 150.0f + 2.0f * B;
    if (tid == 0) cnt[0] = 0u;
    __syncthreads();
    const bool skip = (tid < 4 * qb) && (ch[tid * 64 + 63] * LOG2E > cthr);
    const unsigned long long bal = __ballot(skip);
    if ((tid & 63) == 0 && bal) atomicAdd((unsigned*)cnt, (unsigned)__popcll(bal));
    __syncthreads();
    const int jlo = (int)cnt[0];
    __syncthreads();
    return jlo;
}
__device__ __forceinline__ void phase(const Ptrs& P, LAS unsigned char* lds) {
    unsigned* head = (unsigned*)(P.ws + WS_CTL) + CW_QUEUE;
    LAS unsigned* slot = (LAS unsigned*)(lds + LDS_MISC) + 4;
    for (;;) {
        if (threadIdx.x == 0) slot[0] = atomicAdd(head, 1u);
        __syncthreads();
        const int u = (int)slot[0];
        __syncthreads();
        if (u >= 512 + 256) break;
        if (u < 512) { const int h = u & 7, qb = 63 - (u >> 3);
            const int jlo = first_tile(P, h, qb, lds);
            unit(P, h, qb, jlo, lds); }
        else dil_unit_fwd(P, (u - 512) & 7, (u - 512) >> 3, lds);
    }
}
}

namespace dil {
using fox::crow; using fox::vtr; using fox::cvtpk; using fox::pack8; using fox::s16x4;
constexpr float NEG = -1.0e30f;
constexpr int LDS_V = 0, LDS_BT = 65536, LDS_MISC = 65536 + 2048;

__device__ __forceinline__ void task(const Ptrs& P, int h, int T0, int k, LAS unsigned char* lds, int wave, int lane) {
    const int r32 = lane & 31, hi = lane >> 5, p = k >> 4, g = k & 15;
    const int d = p == 0 ? 1 : (p == 1 ? 4 : 16);
    const int off = p == 0 ? 32 * g : (p == 1 ? (g & 3) + 128 * (g >> 2) : g);
    const int tq0 = T0 + off, tq = tq0 + r32 * d, kbase = tq0 - 128 * d;
    const bf16_t* QKV = (const bf16_t*)(P.ws + WS_QKV);
    const bf16_t* Qd = QKV + 1536 + h * 64; const bf16_t* Kd = QKV + 2048 + h * 64; const bf16_t* Vd = QKV + 2560 + h * 64;
    bf16x8 qr[4];
#pragma unroll
    for (int ds = 0; ds < 4; ++ds) qr[ds] = *(const bf16x8*)(Qd + (size_t)tq * NQKV + ds * 16 + hi * 8);
    const LAS float* bt = (const LAS float*)(lds + LDS_BT) + p * BT_STRIDE;
    LAS unsigned char* vb = lds + LDS_V + wave * 8192;
    float m = NEG, l = 0.f;
    f32x16 o[2];
#pragma unroll
    for (int i = 0; i < 16; ++i) { o[0][i] = 0.f; o[1][i] = 0.f; }
    bf16x8 kfn[4]; u32x4 vrn[4];
#define DIL_LOAD(kt) do { int pk_ = kbase + (32 * (kt) + r32) * d; pk_ = pk_ < 0 ? 0 : pk_; const bf16_t* kp_ = Kd + (size_t)pk_ * NQKV + hi * 8; \
        _Pragma("unroll") for (int ds = 0; ds < 4; ++ds) kfn[ds] = *(const bf16x8*)(kp_ + ds * 16); \
        int pv_ = kbase + (32 * (kt) + (lane >> 1)) * d; pv_ = pv_ < 0 ? 0 : pv_; const bf16_t* vp_ = Vd + (size_t)pv_ * NQKV + (lane & 1) * 32; \
        _Pragma("unroll") for (int c = 0; c < 4; ++c) vrn[c] = *(const u32x4*)(vp_ + c * 8); } while (0)
    DIL_LOAD(0);
#pragma unroll 1
    for (int kt = 0; kt < 5; ++kt) {
        bf16x8 kf[4]; u32x4 vr[4];
#pragma unroll
        for (int i = 0; i < 4; ++i) { kf[i] = kfn[i]; vr[i] = vrn[i]; }
        LAS unsigned char* vbuf = vb + (kt & 1) * 4096;
#pragma unroll
        for (int c = 0; c < 4; ++c) *(LAS u32x4*)(vbuf + (lane & 1) * 2048 + (lane >> 1) * 64 + c * 16) = vr[c];
        if (kt < 4) DIL_LOAD(kt + 1);
        f32x16 s;
#pragma unroll
        for (int i = 0; i < 16; ++i) s[i] = 0.f;
#pragma unroll
        for (int ds = 0; ds < 4; ++ds) s = __builtin_amdgcn_mfma_f32_32x32x16_bf16(kf[ds], qr[ds], s, 0, 0, 0);
#pragma unroll
        for (int r = 0; r < 16; ++r) { const int n = 32 * kt + crow(r, hi), j = r32 + 128 - n; const bool valid = (j >= 0) && (j <= 128) && (kbase + n * d >= 0);
            const int jc = j < 0 ? 0 : (j > 128 ? 128 : j); s[r] = valid ? s[r] + bt[jc] : NEG; }
        float rm = s[0];
#pragma unroll
        for (int r = 1; r < 16; ++r) rm = fmaxf(rm, s[r]);
        rm = fmaxf(rm, __shfl_xor(rm, 32));
        const float mnew = fmaxf(m, rm), alpha = __builtin_amdgcn_exp2f(m - mnew), ms = (mnew < -1.0e29f) ? 0.f : mnew;
        m = mnew;
        float rs = 0.f;
#pragma unroll
        for (int r = 0; r < 16; ++r) { s[r] = __builtin_amdgcn_exp2f(s[r] - ms); rs += s[r]; }
        l = l * alpha + rs;
#pragma unroll
        for (int i = 0; i < 16; ++i) { o[0][i] *= alpha; o[1][i] *= alpha; }
        bf16x8 pb[2]; pb[0] = pack8(s, 0); pb[1] = pack8(s, 1);
        const LAS unsigned char* vp = vbuf + ((lane >> 4) & 1) * 32 + (lane & 3) * 8 + (4 * hi + ((lane & 15) >> 2)) * 64;
#pragma unroll
        for (int d0 = 0; d0 < 2; ++d0)
#pragma unroll
            for (int ks = 0; ks < 2; ++ks) { const s16x4 lo = vtr(vp + d0 * 2048 + ks * 1024), hh = vtr(vp + d0 * 2048 + ks * 1024 + 512);
                const bf16x8 vf = (bf16x8){lo[0], lo[1], lo[2], lo[3], hh[0], hh[1], hh[2], hh[3]};
                o[d0] = __builtin_amdgcn_mfma_f32_32x32x16_bf16(vf, pb[ks], o[d0], 0, 0, 0); }
    }
#undef DIL_LOAD
    l += __shfl_xor(l, 32);
    const float rl = 1.0f / l;
    bf16_t* op = (bf16_t*)(P.ws + WS_DILTMP) + ((size_t)p * SEQ + tq) * 512 + h * 64 + 4 * hi;
#pragma unroll
    for (int d0 = 0; d0 < 2; ++d0)
#pragma unroll
        for (int gg = 0; gg < 4; ++gg) { u32x2 w; w.x = cvtpk(o[d0][4 * gg] * rl, o[d0][4 * gg + 1] * rl); w.y = cvtpk(o[d0][4 * gg + 2] * rl, o[d0][4 * gg + 3] * rl);
            *(u32x2*)(op + 32 * d0 + 8 * gg) = w; }
    if (hi == 0) ((float*)(P.ws + WS_DLSE))[(size_t)(p * 8 + h) * SEQ + tq] = m + __log2f(l);
}

__device__ __forceinline__ void unit(const Ptrs& P, int h, int st, LAS unsigned char* lds) {
    const int tid = threadIdx.x, lane = tid & 63, wave = __builtin_amdgcn_readfirstlane(tid >> 6), T0 = st * 512;
    if (tid < 3 * 129) { const int p = tid / 129, j = tid - p * 129; ((LAS float*)(lds + LDS_BT))[p * BT_STRIDE + j] = ((const float*)(P.ws + WS_BTAB))[(p * 8 + h) * BT_STRIDE + j]; }
    __syncthreads();
    for (int k = wave; k < 48; k += 8) task(P, h, T0, k, lds, wave, lane);
    __syncthreads();
    {
        const int t = T0 + tid; const float* lse = (const float*)(P.ws + WS_DLSE) + (size_t)h * SEQ + t;
        const float l0 = lse[0], l1 = lse[(size_t)8 * SEQ], l2 = lse[(size_t)16 * SEQ], mx = fmaxf(l0, fmaxf(l1, l2));
        float w0 = __builtin_amdgcn_exp2f(l0 - mx), w1 = __builtin_amdgcn_exp2f(l1 - mx), w2 = __builtin_amdgcn_exp2f(l2 - mx); const float rw = 1.0f / (w0 + w1 + w2);
        w0 *= rw; w1 *= rw; w2 *= rw;
        const bf16_t* src = (const bf16_t*)(P.ws + WS_DILTMP) + (size_t)t * 512 + h * 64; bf16_t* dst = (bf16_t*)(P.ws + WS_O) + (size_t)t * DM + 512 + h * 64;
#pragma unroll
        for (int c = 0; c < 8; ++c) { const u32x4 a = *(const u32x4*)(src + c * 8), b = *(const u32x4*)(src + (size_t)SEQ * 512 + c * 8), cc = *(const u32x4*)(src + (size_t)2 * SEQ * 512 + c * 8); u32x4 r;
#pragma unroll
            for (int e = 0; e < 4; ++e) { const float lo = w0 * __uint_as_float(a[e] << 16) + w1 * __uint_as_float(b[e] << 16) + w2 * __uint_as_float(cc[e] << 16);
                const float hh = w0 * __uint_as_float(a[e] & 0xffff0000u) + w1 * __uint_as_float(b[e] & 0xffff0000u) + w2 * __uint_as_float(cc[e] & 0xffff0000u); r[e] = cvtpk(lo, hh); }
            *(u32x4*)(dst + c * 8) = r; }
    }
    __syncthreads();
}
}
__device__ __forceinline__ void dil_unit_fwd(const Ptrs& P, int h, int st, LAS unsigned char* lds) { dil::unit(P, h, st, lds); }

namespace px {
using fox::crow; using fox::cvtpk; using fox::pack8;
constexpr int A_STRIDE = 1040, Q_STRIDE = 528;
constexpr int LDS_A = 0, LDS_Q = 64 * A_STRIDE, LDS_SSQ = LDS_Q + 64 * Q_STRIDE, LDS_RSTD = LDS_SSQ + 8 * 64 * 4;
typedef float f32x2 __attribute__((ext_vector_type(2)));

__device__ __forceinline__ float transpose_reduce16(float (&v)[16], int lane) {
#pragma unroll
    for (int i = 0; i < 8; ++i) { const bool up = lane & 8; const float keep = up ? v[i + 8] : v[i], send = up ? v[i] : v[i + 8]; v[i] = keep + __shfl_xor(send, 8); }
#pragma unroll
    for (int i = 0; i < 4; ++i) { const bool up = lane & 4; const float keep = up ? v[i + 4] : v[i], send = up ? v[i] : v[i + 4]; v[i] = keep + __shfl_xor(send, 4); }
#pragma unroll
    for (int i = 0; i < 2; ++i) { const bool up = lane & 2; const float keep = up ? v[i + 2] : v[i], send = up ? v[i] : v[i + 2]; v[i] = keep + __shfl_xor(send, 2); }
    { const bool up = lane & 1; const float keep = up ? v[1] : v[0], send = up ? v[0] : v[1]; v[0] = keep + __shfl_xor(send, 1); }
    return v[0] + __shfl_xor(v[0], 16);
}

__device__ __forceinline__ void unit(const Ptrs& P, int u, LAS unsigned char* lds) {
    int tid = threadIdx.x; asm volatile("" : "+v"(tid));
    const int lane = tid & 63, wave = __builtin_amdgcn_readfirstlane(tid >> 6), r32 = lane & 31, hi = lane >> 5, t0 = u * 64;
    const bf16_t* H2 = (const bf16_t*)(P.ws + WS_H2); const bf16_t* Wxq = (const bf16_t*)(P.ws + WS_WXQ); const bf16_t* Wxo = (const bf16_t*)(P.ws + WS_WXO);
    const bf16_t* Kmem = (const bf16_t*)(P.ws + WS_KMEM); const bf16_t* VT = (const bf16_t*)(P.ws + WS_VMEM);
    {
        f32x16 acc[2];
#pragma unroll
        for (int i = 0; i < 16; ++i) { acc[0][i] = 0.f; acc[1][i] = 0.f; }
        const bf16_t* bsrc = Wxq + (size_t)(32 * wave + r32) * DM + 8 * hi;
#pragma unroll 1
        for (int half = 0; half < 2; ++half) {
            __syncthreads();
            { const int row = tid >> 3; const bf16_t* src = H2 + (size_t)(t0 + row) * DM + 512 * half;
#pragma unroll
              for (int i = 0; i < 8; ++i) { const int c = (tid & 7) + 8 * i; *(LAS u32x4*)(lds + LDS_A + row * A_STRIDE + c * 16) = *(const u32x4*)(src + c * 8); } }
            __syncthreads();
            const LAS unsigned char* ap = lds + LDS_A + r32 * A_STRIDE + 16 * hi;
#pragma unroll 8
            for (int ks = 0; ks < 32; ++ks) {
                const bf16x8 b = *(const bf16x8*)(bsrc + 512 * half + 16 * ks);
                const bf16x8 a0 = *(const LAS bf16x8*)(ap + 32 * ks), a1 = *(const LAS bf16x8*)(ap + 32 * A_STRIDE + 32 * ks);
                acc[0] = __builtin_amdgcn_mfma_f32_32x32x16_bf16(a0, b, acc[0], 0, 0, 0); acc[1] = __builtin_amdgcn_mfma_f32_32x32x16_bf16(a1, b, acc[1], 0, 0, 0);
            }
        }
#pragma unroll
        for (int tb = 0; tb < 2; ++tb)
#pragma unroll
            for (int i = 0; i < 16; ++i) *(LAS bf16_t*)(lds + LDS_Q + (32 * tb + crow(i, hi)) * Q_STRIDE + (32 * wave + r32) * 2) = (bf16_t)f2bf(acc[tb][i] * C2);
    }
    __syncthreads();
    {
        const int hd = wave >> 1, th = wave & 1;
        LAS unsigned char* qrow = lds + LDS_Q + (32 * th + r32) * Q_STRIDE + hd * 128;
        bf16x8 qr[4];
#pragma unroll
        for (int ds = 0; ds < 4; ++ds) qr[ds] = *(const LAS bf16x8*)(qrow + (16 * ds + 8 * hi) * 2);
        float m = -1.0e30f, l = 0.f;
        f32x16 o[2];
#pragma unroll
        for (int i = 0; i < 16; ++i) { o[0][i] = 0.f; o[1][i] = 0.f; }
        const bf16_t* kbase = Kmem + (size_t)r32 * 256 + hd * 64 + 8 * hi;
        const bf16_t* vbase = VT + (size_t)(hd * 64 + r32) * 256 + 8 * hi;
#pragma unroll 2
        for (int kt = 0; kt < 8; ++kt) {
            f32x16 s;
#pragma unroll
            for (int i = 0; i < 16; ++i) s[i] = 0.f;
#pragma unroll
            for (int ds = 0; ds < 4; ++ds) { const bf16x8 kf = *(const bf16x8*)(kbase + (size_t)(32 * kt) * 256 + 16 * ds); s = __builtin_amdgcn_mfma_f32_32x32x16_bf16(kf, qr[ds], s, 0, 0, 0); }
            float rm = s[0];
#pragma unroll
            for (int r = 1; r < 16; ++r) rm = fmaxf(rm, s[r]);
            rm = fmaxf(rm, __shfl_xor(rm, 32));
            const float mnew = fmaxf(m, rm), alpha = __builtin_amdgcn_exp2f(m - mnew);
            m = mnew;
            float rs = 0.f;
#pragma unroll
            for (int r = 0; r < 16; ++r) { s[r] = __builtin_amdgcn_exp2f(s[r] - mnew); rs += s[r]; }
            l = l * alpha + rs;
#pragma unroll
            for (int i = 0; i < 16; ++i) { o[0][i] *= alpha; o[1][i] *= alpha; }
            bf16x8 pb[2]; pb[0] = pack8(s, 0); pb[1] = pack8(s, 1);
#pragma unroll
            for (int d0 = 0; d0 < 2; ++d0)
#pragma unroll
                for (int ks = 0; ks < 2; ++ks) { const bf16x8 vf = *(const bf16x8*)(vbase + (size_t)(32 * d0) * 256 + 32 * kt + 16 * ks);
                    o[d0] = __builtin_amdgcn_mfma_f32_32x32x16_bf16(vf, pb[ks], o[d0], 0, 0, 0); }
        }
        l += __shfl_xor(l, 32);
        const float rl = 1.0f / l;
#pragma unroll
        for (int d0 = 0; d0 < 2; ++d0)
#pragma unroll
            for (int g = 0; g < 4; ++g) { u32x2 w; w.x = cvtpk(o[d0][4 * g] * rl, o[d0][4 * g + 1] * rl); w.y = cvtpk(o[d0][4 * g + 2] * rl, o[d0][4 * g + 3] * rl);
                *(LAS u32x2*)(qrow + (32 * d0 + 8 * g + 4 * hi) * 2) = w; }
    }
    __syncthreads();
    f32x16 acc[2][4];
#pragma unroll
    for (int tb = 0; tb < 2; ++tb)
#pragma unroll
        for (int nb = 0; nb < 4; ++nb)
#pragma unroll
            for (int i = 0; i < 16; ++i) acc[tb][nb][i] = 0.f;
    {
        const LAS unsigned char* ap = lds + LDS_Q + r32 * Q_STRIDE + 16 * hi;
        const bf16_t* bsrc = Wxo + (size_t)(128 * wave + r32) * 256 + 8 * hi;
#pragma unroll 4
        for (int ks = 0; ks < 16; ++ks) {
            const bf16x8 a0 = *(const LAS bf16x8*)(ap + 32 * ks), a1 = *(const LAS bf16x8*)(ap + 32 * Q_STRIDE + 32 * ks);
#pragma unroll
            for (int nb = 0; nb < 4; ++nb) { const bf16x8 b = *(const bf16x8*)(bsrc + (size_t)(32 * nb) * 256 + 16 * ks);
                acc[0][nb] = __builtin_amdgcn_mfma_f32_32x32x16_bf16(a0, b, acc[0][nb], 0, 0, 0); acc[1][nb] = __builtin_amdgcn_mfma_f32_32x32x16_bf16(a1, b, acc[1][nb], 0, 0, 0); }
        }
    }
    LAS float* SSQ = (LAS float*)(lds + LDS_SSQ); LAS float* RSTD = (LAS float*)(lds + LDS_RSTD);
    const int ncol = 128 * wave + r32;
    float* xrow = P.out + (size_t)t0 * DM + ncol;
#pragma unroll
    for (int tb = 0; tb < 2; ++tb) { float v[16];
#pragma unroll
        for (int i = 0; i < 16; ++i) { float q2 = 0.f;
#pragma unroll
            for (int nb = 0; nb < 4; ++nb) q2 += acc[tb][nb][i] * acc[tb][nb][i];
            v[i] = q2; }
        const float tot = transpose_reduce16(v, lane);
        if ((lane & 16) == 0) SSQ[wave * 64 + 32 * tb + crow(lane & 15, hi)] = tot; }
    __syncthreads();
    if (tid < 64) { float s = 0.f;
#pragma unroll
        for (int w = 0; w < 8; ++w) s += SSQ[w * 64 + tid];
        RSTD[tid] = 1.0f / sqrtf(s * (1.0f / DM) + RMS_EPS); }
    __syncthreads();
    {
        float g1[4];
#pragma unroll
        for (int nb = 0; nb < 4; ++nb) g1[nb] = P.in[14][ncol + 32 * nb];
        float tot2[2];
#pragma unroll
        for (int tb = 0; tb < 2; ++tb) { float v[16];
#pragma unroll
            for (int i = 0; i < 16; ++i) { const int tok = 32 * tb + crow(i, hi); const float rs = RSTD[tok]; float q2 = 0.f;
#pragma unroll
                for (int nb = 0; nb < 4; ++nb) { float* xp = xrow + (size_t)tok * DM + 32 * nb; const float x2 = *xp + acc[tb][nb][i] * rs * g1[nb]; *xp = x2; acc[tb][nb][i] = x2; q2 += x2 * x2; }
                v[i] = q2;
                if ((i & 3) == 3) asm volatile("" ::: "memory"); }
            tot2[tb] = transpose_reduce16(v, lane); }
        __syncthreads();
#pragma unroll
        for (int tb = 0; tb < 2; ++tb) if ((lane & 16) == 0) SSQ[wave * 64 + 32 * tb + crow(lane & 15, hi)] = tot2[tb];
    }
    __syncthreads();
    if (tid < 64) { float s = 0.f;
#pragma unroll
        for (int w = 0; w < 8; ++w) s += SSQ[w * 64 + tid];
        RSTD[tid] = 1.0f / sqrtf(s * (1.0f / DM) + RMS_EPS); }
    __syncthreads();
    {
        float g2[4];
#pragma unroll
        for (int nb = 0; nb < 4; ++nb) g2[nb] = P.in[15][ncol + 32 * nb];
        bf16_t* hrow = (bf16_t*)(P.ws + WS_H3) + (size_t)t0 * DM + ncol;
#pragma unroll
        for (int tb = 0; tb < 2; ++tb)
#pragma unroll
            for (int i = 0; i < 16; ++i) { const int tok = 32 * tb + crow(i, hi); const float rs = RSTD[tok];
#pragma unroll
                for (int nb = 0; nb < 4; ++nb) hrow[(size_t)tok * DM + 32 * nb] = (bf16_t)f2bf(acc[tb][nb][i] * rs * g2[nb]); }
    }
    __syncthreads();
}
}

__device__ __forceinline__ void ph_fox_naive(const Ptrs& P, int vb) {
    const bf16_t* QKV = (const bf16_t*)(P.ws + WS_QKV); bf16_t* O = (bf16_t*)(P.ws + WS_O); const float* cc = (const float*)(P.ws + WS_C);
    const int s = vb * 8 + (threadIdx.x >> 6), h = s & 7, t = (s >> 3) * 64 + (threadIdx.x & 63);
    RowAttn ra; ra.init(QKV + (size_t)t * NQKV + h * 64);
    const float* ch = cc + (size_t)h * SEQ; const float ct = ch[t];
    const int tlast = (t | 63);
    for (int k = 0; k <= tlast; ++k) { const float bias = (k <= t) ? (ct - ch[k]) * LOG2E : -INFINITY;
        ra.key(QKV + (size_t)k * NQKV + 512 + h * 64, QKV + (size_t)k * NQKV + 1024 + h * 64, bias); }
    ra.store(O + (size_t)t * DM + h * 64);
}
__device__ __forceinline__ void ph_dil_naive(const Ptrs& P, int vb) {
    const bf16_t* QKV = (const bf16_t*)(P.ws + WS_QKV); bf16_t* O = (bf16_t*)(P.ws + WS_O); const float* btab = (const float*)(P.ws + WS_BTAB);
    const int s = vb * 8 + (threadIdx.x >> 6), h = s & 7, t = (s >> 3) * 64 + (threadIdx.x & 63);
    RowAttn ra; ra.init(QKV + (size_t)t * NQKV + 1536 + h * 64);
    for (int p = 0; p < 3; ++p) { const int dil = p == 0 ? 1 : (p == 1 ? 4 : 16); const float* bt = btab + (p * 8 + h) * BT_STRIDE;
        for (int j = 0; j <= 128; ++j) { const int k = t - j * dil; if (k < 0) break;
            ra.key(QKV + (size_t)k * NQKV + 2048 + h * 64, QKV + (size_t)k * NQKV + 2560 + h * 64, bt[j]); } }
    ra.store(O + (size_t)t * DM + 512 + h * 64);
}
__device__ __forceinline__ void ph_xattn_naive(const Ptrs& P, int vb, int nb) {
    const bf16_t* QX = (const bf16_t*)(P.ws + WS_QX); bf16_t* OX = (bf16_t*)(P.ws + WS_OX);
    const bf16_t* Kmem = (const bf16_t*)(P.ws + WS_KMEM); const bf16_t* Vmem = (const bf16_t*)(P.ws + WS_VMEM);
    for (int idx = vb * 512 + threadIdx.x; idx < 4 * SEQ; idx += nb * 512) { const int h = idx >> 14, t = idx & (SEQ - 1);
        RowAttn ra; ra.init(QX + (size_t)t * 256 + h * 64);
        for (int k = 0; k < NMEM; ++k) ra.key(Kmem + (size_t)k * 256 + h * 64, Vmem + (size_t)k * 256 + h * 64, 0.f);
        ra.store(OX + (size_t)t * 256 + h * 64); }
}
__device__ __forceinline__ void ph_norm_rows(const float* y, const float* base, const float* g1, float* out, const float* g2, bf16_t* hn, int vb, int nb) {
    const int lane = threadIdx.x & 63;
    for (int m = vb * 8 + (threadIdx.x >> 6); m < SEQ; m += nb * 8) {
        const f32x4* yr = (const f32x4*)(y + (size_t)m * DM) + lane; const f32x4* br = (const f32x4*)(base + (size_t)m * DM) + lane;
        f32x4 v[4]; float ss = 0.f;
#pragma unroll
        for (int j = 0; j < 4; ++j) { v[j] = yr[64 * j]; ss += (v[j].x * v[j].x + v[j].y * v[j].y) + (v[j].z * v[j].z + v[j].w * v[j].w); }
        const float rstd = 1.0f / sqrtf(wave_sum(ss) * (1.0f / DM) + RMS_EPS);
        float s2 = 0.f;
#pragma unroll
        for (int j = 0; j < 4; ++j) { const f32x4 g = ((const f32x4*)g1 + lane)[64 * j]; v[j] = br[64 * j] + v[j] * rstd * g; s2 += (v[j].x * v[j].x + v[j].y * v[j].y) + (v[j].z * v[j].z + v[j].w * v[j].w); }
        f32x4* orow = (f32x4*)(out + (size_t)m * DM) + lane;
#pragma unroll
        for (int j = 0; j < 4; ++j) orow[64 * j] = v[j];
        if (hn) {
            const float r2 = 1.0f / sqrtf(wave_sum(s2) * (1.0f / DM) + RMS_EPS);
            unsigned long long* o8 = (unsigned long long*)(hn + (size_t)m * DM) + lane;
#pragma unroll
            for (int j = 0; j < 4; ++j) { const f32x4 g = ((const f32x4*)g2 + lane)[64 * j]; const f32x4 w = v[j] * r2 * g; o8[64 * j] = (unsigned long long)pk2(w.x, w.y) | ((unsigned long long)pk2(w.z, w.w) << 32); }
        }
    }
}

constexpr int NWAVES = 8;
constexpr int RING_BYTES = 131072, LDSCTL_OFF = RING_BYTES, MISC_OFF = LDSCTL_OFF + 320, LDS_BYTES = 147456;
constexpr int CW_BAR = 4096;
constexpr int N_PHASES = 9;
struct MArgs { Ptrs p; int ph_lo, ph_hi, li, pad; };

__global__ void __launch_bounds__(NWAVES * 64, 2) mega(MArgs a) {
    extern __shared__ __attribute__((aligned(16))) unsigned char lds_raw[];
    LAS unsigned char* lds = (LAS unsigned char*)lds_raw;
    const Ptrs& P = a.p;
    const int tid = threadIdx.x, G = gridDim.x, vb = blockIdx.x;
    for (int u = tid; u < (LDS_BYTES - LDSCTL_OFF) / 4; u += NWAVES * 64) ((LAS unsigned*)(lds + LDSCTL_OFF))[u] = 0u;
    __syncthreads();
    unsigned char* ws = P.ws;
    unsigned* ctl = (unsigned*)(ws + WS_CTL);
    XcdBarrier bar = xcd_barrier_post(ctl + CW_BAR + a.li * XCD_BAR_WORDS, (volatile LAS unsigned*)(lds + MISC_OFF) + 8);
    const int lo = a.ph_lo, hi = a.ph_hi;
#define IN(k) (lo <= (k) && (k) < hi)
#define SEAM(k) do { if (IN(k) && IN((k) + 1)) xcd_barrier(bar); } while (0)
    bf16_t* Win = (bf16_t*)(ws + WS_WIN); bf16_t* Wout = (bf16_t*)(ws + WS_WOUT); bf16_t* Wxq = (bf16_t*)(ws + WS_WXQ); bf16_t* Wxo = (bf16_t*)(ws + WS_WXO);
    bf16_t* Wgu = (bf16_t*)(ws + WS_WGU); bf16_t* Wdn = (bf16_t*)(ws + WS_WDN);
    bf16_t* QKV = (bf16_t*)(ws + WS_QKV); bf16_t* QX = (bf16_t*)(ws + WS_QX); bf16_t* OX = (bf16_t*)(ws + WS_OX); bf16_t* HMID = (bf16_t*)(ws + WS_HMID);
    bf16_t* H1 = (bf16_t*)(ws + WS_H1); bf16_t* H3 = (bf16_t*)(ws + WS_H3); bf16_t* O = (bf16_t*)(ws + WS_O); bf16_t* H2 = (bf16_t*)(ws + WS_H2);
    float* Y = (float*)(ws + WS_Y);

    if (IN(0)) { p0_prologue(P, lds, vb, G); } SEAM(0);
    if (IN(1)) {
        if (vb < 8) cumsum_head(P, vb, lds);
        pg8::Gemm g{H1, Win, SEQ, NQKV, DM}; pg8::StaticOrder S; S.init(SEQ, NQKV, G, vb);
        pg8::EpiQKVp E{QKV, ctl};
        pg8::gemm_phase<pg8::EpiQKVp, pg8::StaticOrder, true, true>(lds, g, S, E);
    } SEAM(1);
    if (IN(2)) { fox::phase(P, lds); } SEAM(2);
    if (IN(3)) {
        pg8::Gemm g{O, Wout, SEQ, DM, DM}; pg8::StaticOrder S; S.init(SEQ, DM, G, vb);
        pg8::EpiF32p E{Y, DM};
        pg8::gemm_phase<pg8::EpiF32p, pg8::StaticOrder, true, true>(lds, g, S, E);
    } SEAM(3);
    if (IN(4)) { ph_norm_rows(Y, P.in[0], P.in[7], P.out, P.in[8], H2, vb, G); } SEAM(4);
    if (IN(5)) { for (int u = vb; u < SEQ / 64; u += G) px::unit(P, u, lds); } SEAM(5);
    if (IN(6)) {
        pg8::Gemm g{H3, Wgu, SEQ, NGU, DM}; pg8::StaticOrder S; S.init(SEQ, NGU, G, vb);
        pg8::EpiSwiGLU E{HMID};
        pg8::gemm_phase<pg8::EpiSwiGLU, pg8::StaticOrder, true, true>(lds, g, S, E);
    } SEAM(6);
    if (IN(7)) {
        pg8::Gemm g{HMID, Wdn, SEQ, DM, DFF}; pg8::StaticOrder S; S.init(SEQ, DM, G, vb);
        pg8::EpiF32p E{Y, DM};
        pg8::gemm_phase<pg8::EpiF32p, pg8::StaticOrder, true, true>(lds, g, S, E);
    } SEAM(7);
    if (IN(8)) { ph_norm_rows(Y, P.out, P.in[19], P.out, (const float*)nullptr, (bf16_t*)nullptr, vb, G); }
#undef IN
#undef SEAM
}

#ifndef MK_CUTS
#define MK_CUTS 0
#endif
extern "C" void kernel_launch(void* const* d_in, const int* in_sizes, int n_in, void* d_out, int out_size, void* d_ws, size_t ws_size, hipStream_t stream) {
    static int grid = 0;
    if (grid == 0) {
        if (n_in != 20 || out_size != SEQ * DM || ws_size < WS_END) { fprintf(stderr, "kernel_launch: unexpected problem (n_in %d out %d ws %zu)\n", n_in, out_size, ws_size); grid = -1; return; }
        int dev = 0, cus = 0, per_cu = 0;
        if (hipGetDevice(&dev) != hipSuccess || hipDeviceGetAttribute(&cus, hipDeviceAttributeMultiprocessorCount, dev) != hipSuccess) { grid = -1; return; }
        if (hipFuncSetAttribute((const void*)mega, hipFuncAttributeMaxDynamicSharedMemorySize, LDS_BYTES) != hipSuccess) { fprintf(stderr, "kernel_launch: hipFuncSetAttribute failed\n"); grid = -1; return; }
        if (hipOccupancyMaxActiveBlocksPerMultiprocessor(&per_cu, (const void*)mega, NWAVES * 64, LDS_BYTES) != hipSuccess || per_cu < 1) { fprintf(stderr, "kernel_launch: occupancy query says %d blocks per CU\n", per_cu); }
        (void)hipGetLastError();
        grid = cus;
    }
    if (grid < 0) return;
    hipMemsetAsync((char*)d_ws + WS_CTL, 0, 1 * MiB, stream);
    MArgs a{};
    for (int i = 0; i < 20; ++i) a.p.in[i] = (const float*)d_in[i];
    a.p.out = (float*)d_out; a.p.ws = (unsigned char*)d_ws;
#if MK_CUTS
    for (int ph = 0; ph < N_PHASES; ++ph) { a.ph_lo = ph; a.ph_hi = ph + 1; a.li = ph; a.pad = 0;
        void* args[] = {&a};
        hipLaunchCooperativeKernel((const void*)mega, dim3(grid), dim3(NWAVES * 64), args, LDS_BYTES, stream); }
#else
    a.ph_lo = 0; a.ph_hi = N_PHASES; a.li = 0; a.pad = 0;
    void* args[] = {&a};
    hipError_t e = hipLaunchCooperativeKernel((const void*)mega, dim3(grid), dim3(NWAVES * 64), args, LDS_BYTES, stream);
    if (e != hipSuccess) fprintf(stderr, "kernel_launch: cooperative launch failed: %s (grid %d)\n", hipGetErrorString(e), grid);
#endif
}
```
